# Optimizing an MI355X kernel written in HIP

```python
import jax
import jax.numpy as jnp
from jax import lax
import numpy as np

D_MODEL = 1024
BATCH = 2
SEQ = 8192
DEPTH = 4

GRID_W = 64
CTX_LEN = 256

N_MIXERS = 3
N_LAYERS_A = (DEPTH + 2) // 3
N_LAYERS_B = (DEPTH + 1) // 3
N_LAYERS_C = DEPTH // 3

A_HEADS = 8
A_QK_DIM = D_MODEL // 2
A_V_DIM = D_MODEL
A_DK = A_QK_DIM // A_HEADS
A_DV = A_V_DIM // A_HEADS
A_CHUNK = 128

B_Q_HEADS = 16
B_KV_HEADS = 4
B_HEAD_DIM = D_MODEL // B_Q_HEADS
B_GROUP = B_Q_HEADS // B_KV_HEADS
B_Q_DIM = B_Q_HEADS * B_HEAD_DIM
B_KV_DIM = B_KV_HEADS * B_HEAD_DIM
B_WINDOW = 128
B_BLOCK = 128
ROPE_BASE = 10000.0

C_CONV_W = 3

MLP_HIDDEN = 4 * D_MODEL
NORM_EPS = 1e-6

kernel_name = 'hybrid_mlstm_swa_shortconv_dit'


def rmsnorm(x, g):
    xf = x.astype(jnp.float32)
    y = xf * lax.rsqrt(jnp.mean(xf * xf, axis=-1, keepdims=True) + NORM_EPS)
    return (y * g.astype(jnp.float32)).astype(x.dtype)


def modulate(x, shift, scale):
    return x * (1 + scale) + shift


def sq_relu_mlp(x, w1, w2):
    return jnp.square(jax.nn.relu(x @ w1)) @ w2


def axial_angles(rows):
    row = jnp.repeat(jnp.arange(rows, dtype=jnp.float32), GRID_W)
    col = jnp.tile(jnp.arange(GRID_W, dtype=jnp.float32), rows)
    n_freq = B_HEAD_DIM // 4
    inv_freq = ROPE_BASE ** (-jnp.arange(n_freq, dtype=jnp.float32) / n_freq)
    return row[:, None] * inv_freq, col[:, None] * inv_freq


def rope_half(x, ang):
    cos = jnp.cos(ang)[None, :, None, :]
    sin = jnp.sin(ang)[None, :, None, :]
    x1, x2 = jnp.split(x.astype(jnp.float32), 2, axis=-1)
    return jnp.concatenate([x1 * cos - x2 * sin, x2 * cos + x1 * sin], axis=-1)


def axial_rope(x, ang_row, ang_col):
    half = x.shape[-1] // 2
    y = jnp.concatenate([rope_half(x[..., :half], ang_row), rope_half(x[..., half:], ang_col)], axis=-1)
    return y.astype(x.dtype)


def sink_softmax(scores, sink):
    m = sink
    for s in scores:
        m = jnp.maximum(m, jnp.max(s, axis=-1))
    ps = [jnp.exp(s - m[..., None]) for s in scores]
    denom = jnp.exp(sink - m)
    for p in ps:
        denom = denom + jnp.sum(p, axis=-1)
    return [p / denom[..., None] for p in ps]


def mlstm_chunk_scan(q, k, v, log_i, log_f, state, with_output):
    n_chunks = q.shape[2] // A_CHUNK

    def chunks(a):
        a = a.reshape(a.shape[:2] + (n_chunks, A_CHUNK) + a.shape[3:])
        return jnp.moveaxis(a, 2, 0)

    tri = jnp.tril(jnp.ones((A_CHUNK, A_CHUNK), dtype=bool))

    def step(carry, inp):
        C, n, m = carry
        qc, kc, vc, li, lf = inp
        b = jnp.cumsum(lf, axis=-1)
        b_end = b[..., -1]
        w_end = b_end[..., None] - b + li
        m_new = jnp.maximum(b_end + m, jnp.max(w_end, axis=-1))
        decay = jnp.exp(b_end + m - m_new)
        ws = jnp.exp(w_end - m_new[..., None])
        C_new = decay[..., None, None] * C + jnp.einsum('bhs,bhsk,bhsv->bhkv', ws, kc, vc)
        n_new = decay[..., None] * n + jnp.einsum('bhs,bhsk->bhk', ws, kc)
        if with_output:
            log_d = jnp.where(tri, b[..., :, None] - b[..., None, :] + li[..., None, :], -jnp.inf)
            inter = b + m[..., None]
            m_comb = jnp.maximum(inter, jnp.max(log_d, axis=-1))
            d_mat = jnp.exp(log_d - m_comb[..., None])
            sc = jnp.einsum('bhtk,bhsk->bhts', qc, kc) * d_mat
            a_inter = jnp.exp(inter - m_comb)
            num = jnp.einsum('bhts,bhsv->bhtv', sc, vc) + a_inter[..., None] * jnp.einsum('bhtk,bhkv->bhtv', qc, C)
            den = jnp.sum(sc, axis=-1) + a_inter * jnp.einsum('bhtk,bhk->bht', qc, n)
            h = num / jnp.maximum(jnp.abs(den), jnp.exp(-m_comb))[..., None]
        else:
            h = None
        return (C_new, n_new, m_new), h

    state, hs = lax.scan(step, state, (chunks(q), chunks(k), chunks(v), chunks(log_i), chunks(log_f)))
    if with_output:
        hs = jnp.moveaxis(hs, 0, 2).reshape(q.shape[:3] + (v.shape[-1],))
    return state, hs


def mlstm_mixer(xc, xl, w_in, w_gate, b_gate, head_g, w_out, ctx_out):
    def project(x):
        bn, L, _ = x.shape
        q, k, v, o = jnp.split(x @ w_in, [A_QK_DIM, 2 * A_QK_DIM, 2 * A_QK_DIM + A_V_DIM], axis=-1)

        def heads(a, d):
            return a.reshape(bn, L, A_HEADS, d).transpose(0, 2, 1, 3).astype(jnp.float32)

        g = (x @ w_gate + b_gate).astype(jnp.float32).transpose(0, 2, 1)
        li_f, lf_f, li_b, lf_b = jnp.split(g, 4, axis=1)
        gates = ((li_f, jax.nn.log_sigmoid(lf_f)), (li_b, jax.nn.log_sigmoid(lf_b)))
        return heads(q, A_DK) * (A_DK ** -0.5), heads(k, A_DK), heads(v, A_DV), o, gates

    def flip(a):
        return jnp.flip(a, axis=2)

    def finish(h, o):
        h = h * lax.rsqrt(jnp.mean(h * h, axis=-1, keepdims=True) + NORM_EPS)
        bn, _, L, _ = h.shape
        h = h.transpose(0, 2, 1, 3).reshape(bn, L, A_V_DIM) * head_g.astype(jnp.float32)
        return (jax.nn.sigmoid(o) * h.astype(o.dtype)) @ w_out

    qc, kc, vc, oc, gc = project(xc)
    ql, kl, vl, ol, gl = project(xl)
    bn = xc.shape[0]
    init = (jnp.zeros((bn, A_HEADS, A_DK, A_DV), jnp.float32),
            jnp.zeros((bn, A_HEADS, A_DK), jnp.float32),
            jnp.full((bn, A_HEADS), -jnp.inf, jnp.float32))
    st_f, hc_f = mlstm_chunk_scan(qc, kc, vc, gc[0][0], gc[0][1], init, ctx_out)
    st_b, hc_b = mlstm_chunk_scan(flip(qc), flip(kc), flip(vc), flip(gc[1][0]), flip(gc[1][1]), init, ctx_out)
    _, hl_f = mlstm_chunk_scan(ql, kl, vl, gl[0][0], gl[0][1], st_f, True)
    _, hl_b = mlstm_chunk_scan(flip(ql), flip(kl), flip(vl), flip(gl[1][0]), flip(gl[1][1]), st_b, True)
    yl = finish(hl_f + flip(hl_b), ol)
    yc = finish(hc_f + flip(hc_b), oc) if ctx_out else None
    return yc, yl


def swa_mixer(xc, xl, w_qkv, sinks, w_out, ang_row, ang_col, ctx_out):
    scale = B_HEAD_DIM ** -0.5

    def project(x, rotate):
        bn, L, _ = x.shape
        q, k, v = jnp.split(x @ w_qkv, [B_Q_DIM, B_Q_DIM + B_KV_DIM], axis=-1)
        q = q.reshape(bn, L, B_Q_HEADS, B_HEAD_DIM)
        k = k.reshape(bn, L, B_KV_HEADS, B_HEAD_DIM)
        v = v.reshape(bn, L, B_KV_HEADS, B_HEAD_DIM)
        if rotate:
            q = axial_rope(q, ang_row, ang_col)
            k = axial_rope(k, ang_row, ang_col)
        return q.reshape(bn, L, B_KV_HEADS, B_GROUP, B_HEAD_DIM), k, v

    sink = sinks.reshape(B_KV_HEADS, B_GROUP).astype(jnp.float32)
    qc, kc, vc = project(xc, False)
    ql, kl, vl = project(xl, True)
    bn, S = xl.shape[:2]
    nb = S // B_BLOCK
    qb = ql.reshape(bn, nb, B_BLOCK, B_KV_HEADS, B_GROUP, B_HEAD_DIM)

    def band(a):
        ap = jnp.pad(a, ((0, 0), (B_BLOCK, B_BLOCK), (0, 0), (0, 0)))
        ap = ap.reshape(bn, nb + 2, B_BLOCK, B_KV_HEADS, B_HEAD_DIM)
        return jnp.concatenate([ap[:, :-2], ap[:, 1:-1], ap[:, 2:]], axis=2)

    kb, vb = band(kl), band(vl)
    blk = jnp.arange(nb)[:, None, None]
    qpos = blk * B_BLOCK + jnp.arange(B_BLOCK)[None, :, None]
    kpos = (blk - 1) * B_BLOCK + jnp.arange(3 * B_BLOCK)[None, None, :]
    mask = (jnp.abs(qpos - kpos) <= B_WINDOW) & (kpos >= 0) & (kpos < S)
    s_loc = jnp.einsum('bnqhgd,bnkhd->bnhgqk', qb, kb).astype(jnp.float32) * scale
    s_loc = jnp.where(mask[None, :, None, None], s_loc, -jnp.inf)
    s_ctx = jnp.einsum('bnqhgd,bchd->bnhgqc', qb, kc).astype(jnp.float32) * scale
    p_loc, p_ctx = sink_softmax([s_loc, s_ctx], sink[None, None, :, :, None])
    o_l = (jnp.einsum('bnhgqk,bnkhd->bnqhgd', p_loc.astype(vb.dtype), vb)
           + jnp.einsum('bnhgqc,bchd->bnqhgd', p_ctx.astype(vc.dtype), vc))
    yl = o_l.reshape(bn, S, D_MODEL) @ w_out
    if ctx_out:
        s_c = jnp.einsum('bqhgd,bkhd->bhgqk', qc, kc).astype(jnp.float32) * scale
        (p_c,) = sink_softmax([s_c], sink[None, :, :, None])
        o_c = jnp.einsum('bhgqk,bkhd->bqhgd', p_c.astype(vc.dtype), vc)
        yc = o_c.reshape(bn, xc.shape[1], D_MODEL) @ w_out
    else:
        yc = None
    return yc, yl


def shortconv_mixer(xc, xl, w_in, conv_w, conv_b, w_out, ctx_out):
    def run(x):
        bg, cg, xt = jnp.split(x @ w_in, 3, axis=-1)
        u = cg * xt
        u = lax.conv_general_dilated(
            u, conv_w[:, None, :].astype(u.dtype), window_strides=(1,),
            padding=((C_CONV_W // 2, C_CONV_W // 2),),
            dimension_numbers=('NWC', 'WIO', 'NWC'), feature_group_count=D_MODEL) + conv_b
        return (bg * u) @ w_out

    return (run(xc) if ctx_out else None), run(xl)


def setup_inputs(seed: int = 0) -> dict:
    key = jax.random.key(seed)
    ks = jax.random.split(key, 24)
    D = D_MODEL
    f32 = jnp.float32

    def nrm(k, shape, fan_in, mult=1.0):
        return jax.random.normal(k, shape, f32) * (mult * fan_in ** -0.5)

    gate_noise = jax.random.normal(ks[9], (N_LAYERS_A, 4, A_HEADS), f32)
    gate_center = jnp.array([0.0, 3.0, 0.0, 3.0], f32)[None, :, None]
    gate_spread = jnp.array([0.1, 0.5, 0.1, 0.5], f32)[None, :, None]
    a_b_gate = (gate_center + gate_spread * gate_noise).reshape(N_LAYERS_A, 4 * A_HEADS)
    return {
        'x': jax.random.normal(ks[0], (BATCH, SEQ, D), f32),
        'c': jax.random.normal(ks[1], (BATCH, D), f32),
        'ctx': jax.random.normal(ks[2], (BATCH, CTX_LEN, D), f32),
        'c_ctx': jax.random.normal(ks[3], (D,), f32),
        'ada_w': nrm(ks[4], (DEPTH, D, 6 * D), D, 0.5),
        'ada_b': 0.02 * jax.random.normal(ks[5], (DEPTH, 6 * D), f32),
        'norm_g': 1.0 + 0.05 * jax.random.normal(ks[6], (DEPTH, 2, D), f32),
        'final_g': 1.0 + 0.05 * jax.random.normal(ks[7], (D,), f32),
        'mlp_w1': nrm(ks[8], (DEPTH, D, MLP_HIDDEN), D),
        'mlp_w2': nrm(ks[10], (DEPTH, MLP_HIDDEN, D), MLP_HIDDEN),
        'a_w_in': nrm(ks[11], (N_LAYERS_A, D, 2 * A_QK_DIM + 2 * A_V_DIM), D),
        'a_w_gate': nrm(ks[12], (N_LAYERS_A, D, 4 * A_HEADS), D, 0.5),
        'a_b_gate': a_b_gate,
        'a_head_g': 1.0 + 0.05 * jax.random.normal(ks[13], (N_LAYERS_A, A_V_DIM), f32),
        'a_w_out': nrm(ks[14], (N_LAYERS_A, A_V_DIM, D), A_V_DIM),
        'b_w_qkv': nrm(ks[15], (N_LAYERS_B, D, B_Q_DIM + 2 * B_KV_DIM), D),
        'b_sinks': 0.5 * jax.random.normal(ks[16], (N_LAYERS_B, B_Q_HEADS), f32),
        'b_w_out': nrm(ks[17], (N_LAYERS_B, B_Q_DIM, D), B_Q_DIM),
        'c_w_in': nrm(ks[18], (N_LAYERS_C, D, 3 * D), D),
        'c_conv_w': nrm(ks[19], (N_LAYERS_C, C_CONV_W, D), C_CONV_W),
        'c_conv_b': 0.02 * jax.random.normal(ks[20], (N_LAYERS_C, D), f32),
        'c_w_out': nrm(ks[21], (N_LAYERS_C, D, D), D),
    }


def reference(x, c, ctx, c_ctx, ada_w, ada_b, norm_g, final_g, mlp_w1, mlp_w2,
              a_w_in, a_w_gate, a_b_gate, a_head_g, a_w_out,
              b_w_qkv, b_sinks, b_w_out, c_w_in, c_conv_w, c_conv_b, c_w_out):
    rows = x.shape[1] // GRID_W
    ang_row, ang_col = axial_angles(rows)
    silu_c = jax.nn.silu(c)
    silu_cc = jax.nn.silu(c_ctx)
    h, hc = x, ctx
    for l in range(DEPTH):
        kind, j = l % N_MIXERS, l // N_MIXERS
        ctx_out = l != DEPTH - 1
        ml = jnp.split(silu_c @ ada_w[l] + ada_b[l], 6, axis=-1)
        mc = jnp.split(silu_cc @ ada_w[l] + ada_b[l], 6, axis=-1)
        xl = modulate(rmsnorm(h, norm_g[l, 0]), ml[0][:, None], ml[1][:, None])
        need_ctx_input = ctx_out or kind != 2
        xc = modulate(rmsnorm(hc, norm_g[l, 0]), mc[0], mc[1]) if need_ctx_input else None
        if kind == 0:
            yc, yl = mlstm_mixer(xc, xl, a_w_in[j], a_w_gate[j], a_b_gate[j], a_head_g[j], a_w_out[j], ctx_out)
        elif kind == 1:
            yc, yl = swa_mixer(xc, xl, b_w_qkv[j], b_sinks[j], b_w_out[j], ang_row, ang_col, ctx_out)
        else:
            yc, yl = shortconv_mixer(xc, xl, c_w_in[j], c_conv_w[j], c_conv_b[j], c_w_out[j], ctx_out)
        h = h + ml[2][:, None] * yl
        xl = modulate(rmsnorm(h, norm_g[l, 1]), ml[3][:, None], ml[4][:, None])
        h = h + ml[5][:, None] * sq_relu_mlp(xl, mlp_w1[l], mlp_w2[l])
        if ctx_out:
            hc = hc + mc[2] * yc
            xc = modulate(rmsnorm(hc, norm_g[l, 1]), mc[3], mc[4])
            hc = hc + mc[5] * sq_relu_mlp(xc, mlp_w1[l], mlp_w2[l])
    return rmsnorm(h, final_g)
```

```cpp
#include <hip/hip_runtime.h>
#include <hip/hip_cooperative_groups.h>
#include <cstdio>
#include <cstdint>
namespace cg = cooperative_groups;

namespace pg8 {
#define PG8_LAS __attribute__((address_space(3)))
typedef unsigned short bf16_t;
typedef short bf16x8 __attribute__((ext_vector_type(8)));
typedef float f32x4 __attribute__((ext_vector_type(4)));
typedef unsigned u32x4 __attribute__((ext_vector_type(4)));
constexpr int BM = 256, BK = 64, HALF = 128, HTB = HALF * BK * 2  , STAGE_BYTES = 8 * HTB, NXCD = 8, WGM = 8;

__host__ __device__ __forceinline__ int lds_byte(int r, int c) { const int st = (r >> 4) * 2 + (c >> 5), rr = r & 15, cc = c & 31, ob = rr * 64 + cc * 2; return st * 1024 + (ob ^ (((ob >> 9) & 1) << 5)); }
__host__ __device__ __forceinline__ void stage_rc(int b, int& R, int& C) { const int st = b / 1024, sb = b % 1024, swz = sb ^ (((sb >> 9) & 1) << 5); R = (st >> 1) * 16 + swz / 64; C = (st & 1) * 32 + (swz % 64) / 2; }
__host__ __device__ __forceinline__ int perm32(int rho) { const int n = rho >> 4, i = rho & 15; return 8 * (i >> 2) + 4 * n + (i & 3); }

struct Unit { int pm, pn; };
struct Gemm { const bf16_t* A; const bf16_t* Bt; int M, N, K; };

struct StaticOrder {
    int nM, nN, nwg, G, c;
    __host__ __device__ void init(int M, int N, int G_, int c_) { nM = M / BM; nN = N / BM; nwg = nM * nN; G = G_; c = c_; }
    __host__ __device__ bool next(int i, Unit& u) const {
        const long L = (long)i * G + c; if (L >= nwg) return false;
        int wgid = (int)L; { const int q = nwg / NXCD, r = nwg % NXCD, xcd = wgid % NXCD, off = wgid / NXCD; wgid = (xcd < r ? xcd * (q + 1) : r * (q + 1) + (xcd - r) * q) + off; }
        const int nig = WGM * nN, gid = wgid / nig, fm = gid * WGM, gsz = (nM - fm) < WGM ? (nM - fm) : WGM;
        u.pm = fm + ((wgid % nig) % gsz); u.pn = (wgid % nig) / gsz; return true;
    }
    __device__ __forceinline__ void a_ready(const Unit&) const {}
    __device__ __forceinline__ void done(const Unit&) const {}
};

__device__ __forceinline__ unsigned cvt_pk_bf16(float lo, float hi) { unsigned r; asm volatile("v_cvt_pk_bf16_f32 %0, %1, %2" : "=v"(r) : "v"(lo), "v"(hi)); return r; }
typedef float f32x2 __attribute__((ext_vector_type(2)));
typedef unsigned u32x2 __attribute__((ext_vector_type(2)));
constexpr int ROWS_LAT = 16384;

template <int ACT> struct EpiStore {
    static constexpr bool PERM = true, AFTER_DRAIN = false;
    bf16_t* O; int ldc;
    __device__ __forceinline__ void operator()(const f32x4 (&acc)[2][2][4][2], const Unit& u, int wr, int wc, int fr, int fq) const {
        const int row0 = u.pm * BM + wr * 64 + fr, col0 = u.pn * BM + wc * 32 + 8 * fq;
#pragma unroll
        for (int ai = 0; ai < 2; ++ai)
#pragma unroll
            for (int m = 0; m < 4; ++m) { bf16_t* rowp = O + (size_t)(row0 + ai * HALF + m * 16) * ldc + col0;
#pragma unroll
                for (int bj = 0; bj < 2; ++bj) { f32x4 v0 = acc[ai][bj][m][0], v1 = acc[ai][bj][m][1];
                    if (ACT == 1) {
#pragma unroll
                        for (int e = 0; e < 4; ++e) { float a = fmaxf(v0[e], 0.f), b = fmaxf(v1[e], 0.f); v0[e] = a * a; v1[e] = b * b; } }
                    u32x4 w; w.x = cvt_pk_bf16(v0[0], v0[1]); w.y = cvt_pk_bf16(v0[2], v0[3]); w.z = cvt_pk_bf16(v1[0], v1[1]); w.w = cvt_pk_bf16(v1[2], v1[3]);
                    *(u32x4*)(rowp + bj * HALF) = w; } }
    }
};
struct EpiAIn {
    static constexpr bool PERM = true, AFTER_DRAIN = false;
    bf16_t* O; float* G; const float* bg;
    __device__ __forceinline__ void operator()(const f32x4 (&acc)[2][2][4][2], const Unit& u, int wr, int wc, int fr, int fq) const {
        const int row0 = u.pm * BM + wr * 64 + fr;
        if (u.pn < 12) {
            const int col0 = u.pn * BM + wc * 32 + 8 * fq;
#pragma unroll
            for (int ai = 0; ai < 2; ++ai)
#pragma unroll
                for (int m = 0; m < 4; ++m) { bf16_t* rowp = O + (size_t)(row0 + ai * HALF + m * 16) * 3072 + col0;
#pragma unroll
                    for (int bj = 0; bj < 2; ++bj) { const f32x4 v0 = acc[ai][bj][m][0], v1 = acc[ai][bj][m][1];
                        u32x4 w; w.x = cvt_pk_bf16(v0[0], v0[1]); w.y = cvt_pk_bf16(v0[2], v0[3]); w.z = cvt_pk_bf16(v1[0], v1[1]); w.w = cvt_pk_bf16(v1[2], v1[3]);
                        *(u32x4*)(rowp + bj * HALF) = w; } }
        } else if (wc == 0) {
            const f32x4 b0 = *(const f32x4*)(bg + 8 * fq), b1 = *(const f32x4*)(bg + 8 * fq + 4);
#pragma unroll
            for (int ai = 0; ai < 2; ++ai)
#pragma unroll
                for (int m = 0; m < 4; ++m) { float* gp = G + (size_t)(row0 + ai * HALF + m * 16) * 32 + 8 * fq;
                    *(f32x4*)gp = acc[ai][0][m][0] + b0; *(f32x4*)(gp + 4) = acc[ai][0][m][1] + b1; }
        }
    }
};
struct EpiQkvRope {
    static constexpr bool PERM = false, AFTER_DRAIN = false;
    bf16_t* O; const float* ct; const float* st;
    __device__ __forceinline__ void operator()(const f32x4 (&acc)[2][2][4][2], const Unit& u, int wr, int wc, int fr, int fq) const {
        const int colb = u.pn * BM + wc * 32 + 4 * fq;
        const bool rope = (u.pm < 64) && (u.pn < 5);
        const float sc = (u.pn < 4) ? 0.18033688011112042f : 1.0f;
#pragma unroll
        for (int ai = 0; ai < 2; ++ai)
#pragma unroll
            for (int m = 0; m < 4; ++m) { const int row = u.pm * BM + ai * HALF + wr * 64 + m * 16 + fr;
                f32x4 c = (f32x4){1.f, 1.f, 1.f, 1.f}, s = (f32x4){0.f, 0.f, 0.f, 0.f};
                if (rope) { const int sq = row & 8191; const int pos = (wc & 1) ? (sq & 63) : (sq >> 6); c = *(const f32x4*)(ct + pos * 16 + 4 * fq); s = *(const f32x4*)(st + pos * 16 + 4 * fq); }
                bf16_t* rowp = O + (size_t)row * 1536 + colb;
#pragma unroll
                for (int bj = 0; bj < 2; ++bj) { const f32x4 x1 = acc[ai][bj][m][0], x2 = acc[ai][bj][m][1];
                    const f32x4 o1 = (x1 * c - x2 * s) * sc, o2 = (x2 * c + x1 * s) * sc;
                    u32x2 w1, w2; w1.x = cvt_pk_bf16(o1[0], o1[1]); w1.y = cvt_pk_bf16(o1[2], o1[3]); w2.x = cvt_pk_bf16(o2[0], o2[1]); w2.y = cvt_pk_bf16(o2[2], o2[3]);
                    *(u32x2*)(rowp + bj * HALF) = w1; *(u32x2*)(rowp + bj * HALF + 16) = w2; } }
    }
};
struct EpiResid {
    static constexpr bool PERM = false, AFTER_DRAIN = false;
    float* hl; float* hc; const float* gate;
    __device__ __forceinline__ void operator()(const f32x4 (&acc)[2][2][4][2], const Unit& u, int wr, int wc, int fr, int fq) const {
        const int r = (u.pm < 64) ? (u.pm >> 5) : 2;
        float* hb = (u.pm < 64) ? hl : (hc - (size_t)ROWS_LAT * 1024);
        const int col0 = u.pn * BM + wc * 32 + 4 * fq;
        const float* gp = gate + r * 6144 + col0;
        f32x4 gv[2][2];
#pragma unroll
        for (int bj = 0; bj < 2; ++bj)
#pragma unroll
            for (int n = 0; n < 2; ++n) gv[bj][n] = *(const f32x4*)(gp + bj * HALF + n * 16);
#pragma unroll
        for (int ai = 0; ai < 2; ++ai)
#pragma unroll
            for (int m = 0; m < 4; ++m) { float* p = hb + (size_t)(u.pm * BM + ai * HALF + wr * 64 + m * 16 + fr) * 1024 + col0;
#pragma unroll
                for (int bj = 0; bj < 2; ++bj)
#pragma unroll
                    for (int n = 0; n < 2; ++n) { f32x4 hv = *(const f32x4*)(p + bj * HALF + n * 16); hv = hv + gv[bj][n] * acc[ai][bj][m][n]; *(f32x4*)(p + bj * HALF + n * 16) = hv; }
                if (m & 1) asm volatile("" ::: "memory"); }
    }
};


__device__ __forceinline__ float shx_pg(float v, int o, int lane) { return __builtin_bit_cast(float, __builtin_amdgcn_ds_bpermute((lane ^ o) << 2, __builtin_bit_cast(int, v))); }
struct EpiResidNorm {
    static constexpr bool PERM = false, AFTER_DRAIN = true;
    float* h; bf16_t* xn; const float* gate; const float* g; const float* shift; const float* scale; unsigned* xslots; unsigned* cnt; int fin;
    __device__ __forceinline__ void operator()(const f32x4 (&)[2][2][4][2], const Unit&, int, int, int, int) const {}
    __device__ __forceinline__ void fused(f32x4 (&acc)[2][2][4][2], const Unit& u, int wr, int wc, int fr, int fq, PG8_LAS unsigned char* lds, int wid, int lane) const {
        const int r = u.pm >> 5, col0 = u.pn * BM + wc * 32 + 4 * fq;
        PG8_LAS float* Pl = (PG8_LAS float*)lds; PG8_LAS float* Sl = (PG8_LAS float*)(lds + 4096);
        {
            const float* gp = gate + r * 6144 + col0; f32x4 gv[2][2];
#pragma unroll
            for (int bj = 0; bj < 2; ++bj)
#pragma unroll
                for (int n = 0; n < 2; ++n) gv[bj][n] = *(const f32x4*)(gp + bj * HALF + n * 16);
#pragma unroll
            for (int ai = 0; ai < 2; ++ai)
#pragma unroll
                for (int m = 0; m < 4; ++m) { const float* p = h + (size_t)(u.pm * BM + ai * HALF + wr * 64 + m * 16 + fr) * 1024 + col0;
#pragma unroll
                    for (int bj = 0; bj < 2; ++bj)
#pragma unroll
                        for (int n = 0; n < 2; ++n) { const f32x4 hv = *(const f32x4*)(p + bj * HALF + n * 16); acc[ai][bj][m][n] = hv + gv[bj][n] * acc[ai][bj][m][n]; }
                    asm volatile("" : "+v"(acc[ai][0][m][0]), "+v"(acc[ai][0][m][1]), "+v"(acc[ai][1][m][0]), "+v"(acc[ai][1][m][1]) :: "memory"); }
        }
#pragma unroll
        for (int ai = 0; ai < 2; ++ai)
#pragma unroll
            for (int m = 0; m < 4; ++m) { float s = 0.f;
#pragma unroll
                for (int bj = 0; bj < 2; ++bj)
#pragma unroll
                    for (int n = 0; n < 2; ++n) { const f32x4 x = acc[ai][bj][m][n]; s += (x[0] * x[0] + x[1] * x[1]) + (x[2] * x[2] + x[3] * x[3]); }
                s += shx_pg(s, 16, lane); s += shx_pg(s, 32, lane);
                if (fq == 0) Pl[(ai * HALF + wr * 64 + m * 16 + fr) * 4 + wc] = s; }
        asm volatile("s_waitcnt lgkmcnt(0)" ::: "memory"); __builtin_amdgcn_s_barrier(); asm volatile("" ::: "memory");
        const int tid = wid * 64 + lane;
        if (tid < 256) { const float tot = (Pl[tid * 4 + 0] + Pl[tid * 4 + 1]) + (Pl[tid * 4 + 2] + Pl[tid * 4 + 3]);
            __hip_atomic_store(xslots + ((size_t)(u.pm * BM + tid)) * 4 + u.pn, __builtin_bit_cast(unsigned, tot), __ATOMIC_RELAXED, __HIP_MEMORY_SCOPE_AGENT); }
        asm volatile("s_waitcnt vmcnt(0)" ::: "memory");
        if (wid < 4 && lane == 0) __hip_atomic_fetch_add(cnt + 64 * u.pm, 1u, __ATOMIC_RELAXED, __HIP_MEMORY_SCOPE_AGENT);
        if (wid == 0) { unsigned sp = 0;
            while ((unsigned)__builtin_amdgcn_readfirstlane((int)__hip_atomic_load(cnt + 64 * u.pm, __ATOMIC_RELAXED, __HIP_MEMORY_SCOPE_AGENT)) < 16u) { __builtin_amdgcn_s_sleep(2); if (++sp > (1u << 22)) break; }
            __builtin_amdgcn_fence(__ATOMIC_ACQUIRE, "agent"); }
        asm volatile("s_waitcnt vmcnt(0) lgkmcnt(0)" ::: "memory"); __builtin_amdgcn_s_barrier(); asm volatile("" ::: "memory");
        if (tid < 256) { const unsigned* sl = xslots + ((size_t)(u.pm * BM + tid)) * 4; float q = 0.f;
#pragma unroll
            for (int t = 0; t < 4; ++t) q += __builtin_bit_cast(float, __hip_atomic_load(sl + t, __ATOMIC_RELAXED, __HIP_MEMORY_SCOPE_AGENT));
            Sl[tid] = __builtin_amdgcn_rsqf(q * (1.0f / 1024.0f) + 1e-6f); }
        asm volatile("s_waitcnt lgkmcnt(0)" ::: "memory"); __builtin_amdgcn_s_barrier(); asm volatile("" ::: "memory");
        f32x4 gm[2][2], sh[2][2];
#pragma unroll
        for (int bj = 0; bj < 2; ++bj)
#pragma unroll
            for (int n = 0; n < 2; ++n) { const int c = col0 + bj * HALF + n * 16; const f32x4 gg = *(const f32x4*)(g + c);
                if (fin) { gm[bj][n] = gg; sh[bj][n] = (f32x4){0.f, 0.f, 0.f, 0.f}; }
                else { gm[bj][n] = gg * (*(const f32x4*)(scale + r * 6144 + c) + 1.0f); sh[bj][n] = *(const f32x4*)(shift + r * 6144 + c); } }
#pragma unroll
        for (int ai = 0; ai < 2; ++ai)
#pragma unroll
            for (int m = 0; m < 4; ++m) { const int rl = ai * HALF + wr * 64 + m * 16 + fr; const float rs = Sl[rl]; const size_t off = (size_t)(u.pm * BM + rl) * 1024 + col0;
#pragma unroll
                for (int bj = 0; bj < 2; ++bj)
#pragma unroll
                    for (int n = 0; n < 2; ++n) { const f32x4 x = acc[ai][bj][m][n];
                        if (fin) { *(f32x4*)(h + off + bj * HALF + n * 16) = (x * rs) * gm[bj][n]; }
                        else { *(f32x4*)(h + off + bj * HALF + n * 16) = x; const f32x4 y = (x * rs) * gm[bj][n] + sh[bj][n];
                            u32x2 w; w.x = cvt_pk_bf16(y[0], y[1]); w.y = cvt_pk_bf16(y[2], y[3]); *(u32x2*)(xn + off + bj * HALF + n * 16) = w; } }
                asm volatile("" ::: "memory"); }
    }
};

template <class Epi, class Sched, bool ALIGN_EPI = false, bool SP2 = false>
__device__ __forceinline__ void gemm_phase(PG8_LAS unsigned char* lds, const Gemm g, const Sched& S, const Epi& E) {
    int tid_ = threadIdx.x; asm volatile("" : "+v"(tid_)); const int tid = tid_, wid = __builtin_amdgcn_readfirstlane(tid >> 6), lane = tid & 63, wr = wid >> 2, wc = wid & 3, fr = lane & 15, fq = lane >> 4;
    const int K = g.K, nt = K / BK;
    unsigned voffA[2], voffB[2];
#pragma unroll
    for (int i = 0; i < 2; ++i) { int R, C; stage_rc(tid * 16 + i * 8192, R, C); const int Rb = Epi::PERM ? ((R & ~31) + perm32(R & 31)) : R;
        voffA[i] = (unsigned)(R * K + C) * 2u; voffB[i] = (unsigned)(Rb * K + C) * 2u; }
    const size_t kstep = (size_t)(BK * 2);
    const size_t hstep = (size_t)HALF * K * 2;
    const size_t tstep = 2 * hstep;
    const unsigned ldsw = (unsigned)wid * 1024u;
    const int aoff = lds_byte(wr * 64 + fr, fq * 8), boff = lds_byte(wc * 32 + fr, fq * 8);
#define PG8_SA(b, h) (((b) * 2 + (h)) * HTB)
#define PG8_SB(b, h) ((4 + (b) * 2 + (h)) * HTB)
#define PG8_STAGE(bufoff, gbase, voff) do { _Pragma("unroll") for (int _i = 0; _i < 2; ++_i) \
        __builtin_amdgcn_global_load_lds((const unsigned*)((const char*)(gbase) + (voff)[_i]), (PG8_LAS unsigned*)(lds + (bufoff) + ldsw + _i * 8192), 16, 0, 0); } while (0)
#define PG8_LDA(dst, b, h) do { _Pragma("unroll") for (int m = 0; m < 4; ++m) _Pragma("unroll") for (int k = 0; k < 2; ++k) dst[m][k] = *(const PG8_LAS bf16x8*)(lds + PG8_SA(b, h) + aoff + m * 2048 + k * 1024); } while (0)
#define PG8_LDB(dst, b, h) do { _Pragma("unroll") for (int n = 0; n < 2; ++n) _Pragma("unroll") for (int k = 0; k < 2; ++k) dst[n][k] = *(const PG8_LAS bf16x8*)(lds + PG8_SB(b, h) + boff + n * 2048 + k * 1024); } while (0)
#define PG8_MMA(ai, bj, At, Bt) do { __builtin_amdgcn_s_setprio(1); _Pragma("unroll") for (int m = 0; m < 4; ++m) _Pragma("unroll") for (int n = 0; n < 2; ++n) _Pragma("unroll") for (int k = 0; k < 2; ++k) \
        acc[ai][bj][m][n] = __builtin_amdgcn_mfma_f32_16x16x32_bf16(Bt[n][k], At[m][k], acc[ai][bj][m][n], 0, 0, 0); __builtin_amdgcn_s_setprio(0); } while (0)
#define PG8_WAIT_V(n) asm volatile("s_waitcnt vmcnt(" #n ")" ::: "memory")
#define PG8_WAIT_L(n) asm volatile("s_waitcnt lgkmcnt(" #n ")" ::: "memory")
#define PG8_BAR __builtin_amdgcn_s_barrier()
#define PG8_SCHED __builtin_amdgcn_sched_barrier(0)
    Unit cur, nxt; int ui = 0;
    if (!S.next(0, cur)) return;
    f32x4 acc[2][2][4][2];
#pragma unroll
    for (int a = 0; a < 2; ++a)
#pragma unroll
        for (int b = 0; b < 2; ++b)
#pragma unroll
            for (int m = 0; m < 4; ++m)
#pragma unroll
                for (int n = 0; n < 2; ++n) acc[a][b][m][n] = (f32x4){0.f, 0.f, 0.f, 0.f};
    bf16x8 At[4][2], B0[2][2], B1[2][2];
    const char* cA = (const char*)g.A + (size_t)cur.pm * tstep; const char* cB = (const char*)g.Bt + (size_t)cur.pn * tstep;
    S.a_ready(cur);
    if constexpr (SP2) {
        PG8_STAGE(PG8_SB(0, 0), cB, voffB); PG8_STAGE(PG8_SB(0, 1), cB + hstep, voffB); PG8_STAGE(PG8_SA(0, 0), cA, voffA); PG8_STAGE(PG8_SA(0, 1), cA + hstep, voffA);
        if (wr == 1) PG8_BAR;
        PG8_WAIT_V(2); PG8_BAR;
        PG8_STAGE(PG8_SB(1, 0), cB + kstep, voffB); PG8_STAGE(PG8_SA(1, 0), cA + kstep, voffA); PG8_STAGE(PG8_SB(1, 1), cB + hstep + kstep, voffB);
        PG8_WAIT_V(6); PG8_BAR;
    } else {
        PG8_STAGE(PG8_SB(0, 0), cB, voffB); PG8_STAGE(PG8_SA(0, 0), cA, voffA); PG8_STAGE(PG8_SB(0, 1), cB + hstep, voffB); PG8_STAGE(PG8_SA(0, 1), cA + hstep, voffA);
        if (wr == 1) PG8_BAR;
        PG8_WAIT_V(4); PG8_BAR;
        PG8_STAGE(PG8_SB(1, 0), cB + kstep, voffB); PG8_STAGE(PG8_SA(1, 0), cA + kstep, voffA); PG8_STAGE(PG8_SB(1, 1), cB + hstep + kstep, voffB);
        PG8_WAIT_V(6); PG8_BAR;
    }
    for (;;) {
        const bool has_next = S.next(ui + 1, nxt);
        const char* nA = has_next ? (const char*)g.A + (size_t)nxt.pm * tstep : cA; const char* nB = has_next ? (const char*)g.Bt + (size_t)nxt.pn * tstep : cB;
        for (int t = 0; t < nt; t += 2) {
            const bool last = (t == nt - 2);
            const char* a1 = cA + (size_t)(t + 1) * kstep;
            const char* a2 = last ? nA : cA + (size_t)(t + 2) * kstep; const char* b2 = last ? nB : cB + (size_t)(t + 2) * kstep;
            const char* a3 = a2 + kstep; const char* b3 = b2 + kstep;
            if (last && has_next) S.a_ready(nxt);
            if constexpr (SP2) {
            PG8_LDB(B0, 0, 0); PG8_LDB(B1, 0, 1); PG8_SCHED; PG8_LDA(At, 0, 0); PG8_STAGE(PG8_SA(1, 1), a1 + hstep, voffA);
            PG8_WAIT_V(8); PG8_WAIT_L(0); PG8_BAR; PG8_MMA(0, 0, At, B0); PG8_MMA(0, 1, At, B1); PG8_BAR; PG8_SCHED;
            PG8_LDA(At, 0, 1); PG8_STAGE(PG8_SB(0, 0), b2, voffB); PG8_STAGE(PG8_SB(0, 1), b2 + hstep, voffB); PG8_STAGE(PG8_SA(0, 0), a2, voffA);
            PG8_WAIT_V(8); PG8_WAIT_L(0); PG8_BAR; PG8_MMA(1, 0, At, B0); PG8_MMA(1, 1, At, B1); PG8_BAR; PG8_SCHED;
            PG8_LDB(B0, 1, 0); PG8_LDB(B1, 1, 1); PG8_SCHED; PG8_LDA(At, 1, 0); PG8_STAGE(PG8_SA(0, 1), a2 + hstep, voffA);
            PG8_WAIT_V(8); PG8_WAIT_L(0); PG8_BAR; PG8_MMA(0, 0, At, B0); PG8_MMA(0, 1, At, B1); PG8_BAR; PG8_SCHED;
            PG8_LDA(At, 1, 1); PG8_STAGE(PG8_SB(1, 0), b3, voffB); PG8_STAGE(PG8_SB(1, 1), b3 + hstep, voffB); PG8_STAGE(PG8_SA(1, 0), a3, voffA);
            PG8_WAIT_V(8); PG8_WAIT_L(0); PG8_BAR; PG8_MMA(1, 0, At, B0); PG8_MMA(1, 1, At, B1); PG8_BAR; PG8_SCHED;
            } else {
            PG8_LDB(B0, 0, 0); PG8_SCHED; PG8_LDA(At, 0, 0); PG8_STAGE(PG8_SA(1, 1), a1 + hstep, voffA);
            PG8_WAIT_L(8); PG8_BAR; PG8_WAIT_L(0); PG8_MMA(0, 0, At, B0); PG8_BAR; PG8_SCHED;
            PG8_LDB(B1, 0, 1); PG8_STAGE(PG8_SB(0, 0), b2, voffB);
            PG8_BAR; PG8_WAIT_L(0); PG8_MMA(0, 1, At, B1); PG8_BAR;
            PG8_LDA(At, 0, 1); PG8_STAGE(PG8_SA(0, 0), a2, voffA);
            PG8_BAR; PG8_WAIT_L(0); PG8_MMA(1, 0, At, B0); PG8_BAR; PG8_SCHED;
            PG8_STAGE(PG8_SB(0, 1), b2 + hstep, voffB);
            PG8_WAIT_V(6); PG8_BAR; PG8_MMA(1, 1, At, B1); PG8_BAR;
            PG8_LDB(B0, 1, 0); PG8_SCHED; PG8_LDA(At, 1, 0); PG8_STAGE(PG8_SA(0, 1), a2 + hstep, voffA);
            PG8_WAIT_L(8); PG8_BAR; PG8_WAIT_L(0); PG8_MMA(0, 0, At, B0); PG8_BAR; PG8_SCHED;
            PG8_LDB(B1, 1, 1); PG8_STAGE(PG8_SB(1, 0), b3, voffB);
            PG8_BAR; PG8_WAIT_L(0); PG8_MMA(0, 1, At, B1); PG8_BAR;
            PG8_LDA(At, 1, 1); PG8_STAGE(PG8_SA(1, 0), a3, voffA);
            PG8_BAR; PG8_WAIT_L(0); PG8_MMA(1, 0, At, B0); PG8_BAR; PG8_SCHED;
            PG8_STAGE(PG8_SB(1, 1), b3 + hstep, voffB);
            PG8_WAIT_V(6); PG8_BAR; PG8_MMA(1, 1, At, B1); PG8_BAR;
            }
        }
        if constexpr (ALIGN_EPI) { if (wr == 0) PG8_BAR; }
        if constexpr (!Epi::AFTER_DRAIN) { E(acc, cur, wr, wc, fr, fq); S.done(cur); }
        if (!has_next) break;
#pragma unroll
        for (int a = 0; a < 2; ++a)
#pragma unroll
            for (int b = 0; b < 2; ++b)
#pragma unroll
                for (int m = 0; m < 4; ++m)
#pragma unroll
                    for (int n = 0; n < 2; ++n) acc[a][b][m][n] = (f32x4){0.f, 0.f, 0.f, 0.f};
        cur = nxt; cA = nA; cB = nB; ++ui;
        if constexpr (ALIGN_EPI) { if (wr == 1) PG8_BAR; }
    }
    PG8_WAIT_V(0);
    if constexpr (!ALIGN_EPI) { if (wr == 0) PG8_BAR; }
    PG8_BAR;
    if constexpr (Epi::AFTER_DRAIN) { E.fused(acc, cur, wr, wc, fr, fq, lds, wid, lane); S.done(cur); }
#undef PG8_SA
#undef PG8_SB
#undef PG8_STAGE
#undef PG8_LDA
#undef PG8_LDB
#undef PG8_MMA
#undef PG8_WAIT_V
#undef PG8_WAIT_L
#undef PG8_BAR
#undef PG8_SCHED
}
}

#define LAS __attribute__((address_space(3)))
typedef unsigned short bf16;
typedef float f32x4 __attribute__((ext_vector_type(4)));
typedef short bf16x8 __attribute__((ext_vector_type(8)));
typedef unsigned v4u __attribute__((ext_vector_type(4)));
typedef unsigned v2u __attribute__((ext_vector_type(2)));
constexpr int NWAVES = 8, NTHR = 512;
constexpr int D = 1024, SEQ = 8192, NBATCH = 2, CTXL = 256, FF = 4096;
constexpr int ML = NBATCH * SEQ, MT = ML + NBATCH * CTXL;
constexpr int NCH = 66;
constexpr int LDS_BYTES = 147456, PARAM_OFF = 131072 + 1024;
constexpr float NEG_BIG = -1.0e30f;

constexpr size_t MiB = 1u << 20;
constexpr size_t WS_MOD = 0;
constexpr size_t WS_ROPE = 512 * 1024;
constexpr size_t WS_MISC = 768 * 1024;
constexpr size_t WS_W1 = 1 * MiB;
constexpr size_t WS_W2 = WS_W1 + 32 * MiB;
constexpr size_t WS_AIN = WS_W2 + 32 * MiB;
constexpr size_t WS_AOUT = WS_AIN + 13 * MiB;
constexpr size_t WS_BQKV = WS_AOUT + 4 * MiB;
constexpr size_t WS_BOUT = WS_BQKV + 3 * MiB;
constexpr size_t WS_CIN = WS_BOUT + 2 * MiB;
constexpr size_t WS_COUT = WS_CIN + 6 * MiB;
constexpr size_t WS_HC = WS_COUT + 2 * MiB;
constexpr size_t WS_XN = WS_HC + 2 * MiB;
constexpr size_t WS_HG = WS_XN + 33 * MiB;
constexpr size_t WS_G = WS_HG + 33 * MiB;
constexpr size_t WS_DN = WS_G + 3 * MiB;
constexpr size_t WS_ACT = WS_DN + 1 * MiB;
constexpr size_t WS_DC = WS_XN;
constexpr size_t WS_CP = WS_ACT + 132 * MiB;
constexpr size_t WS_PART = WS_CP + 33 * MiB;
constexpr size_t WS_XCNT = WS_PART + 8 * MiB;
constexpr size_t XCNT_BYTES = 8 * 64 * 256 + 16 * 256;
constexpr size_t WS_BAR = WS_XCNT + 192 * 1024;
constexpr size_t ZERO_BYTES = 192 * 1024 + 16384;
constexpr size_t WS_XSLOT = WS_XCNT + 256 * 1024;
constexpr size_t WS_END = WS_XSLOT + 2 * MiB;

struct Params {
    const float *x, *c, *ctx, *c_ctx, *ada_w, *ada_b, *norm_g, *final_g, *mlp_w1, *mlp_w2;
    const float *a_w_in, *a_w_gate, *a_b_gate, *a_head_g, *a_w_out, *b_w_qkv, *b_sinks, *b_w_out, *c_w_in, *c_conv_w, *c_conv_b, *c_w_out;
    float* out; unsigned char* ws;
};

__device__ __forceinline__ unsigned f2bf(float f) { unsigned u = __builtin_bit_cast(unsigned, f); return (u + 0x7fffu + ((u >> 16) & 1u)) >> 16; }
typedef float f32x2_t __attribute__((ext_vector_type(2)));
typedef __bf16 bf16x2_t __attribute__((ext_vector_type(2)));
__device__ __forceinline__ unsigned pk2(float lo, float hi) { const f32x2_t v = {lo, hi}; const bf16x2_t b = __builtin_convertvector(v, bf16x2_t); return __builtin_bit_cast(unsigned, b); }
__device__ __forceinline__ float bf2f(unsigned short u) { return __builtin_bit_cast(float, (unsigned)u << 16); }
__device__ __forceinline__ float bflo(unsigned w) { return __builtin_bit_cast(float, w << 16); }
__device__ __forceinline__ float bfhi(unsigned w) { return __builtin_bit_cast(float, w & 0xffff0000u); }
__device__ __forceinline__ float shx(float v, int o, int lane) { return __builtin_bit_cast(float, __builtin_amdgcn_ds_bpermute((lane ^ o) << 2, __builtin_bit_cast(int, v))); }
__device__ __forceinline__ float shup(float v, int o, int lane) { const int src = lane >= o ? lane - o : lane; return __builtin_bit_cast(float, __builtin_amdgcn_ds_bpermute(src << 2, __builtin_bit_cast(int, v))); }
__device__ __forceinline__ float wave_sum(float v, int lane) {
#pragma unroll
    for (int o = 1; o < 64; o <<= 1) v += shx(v, o, lane);
    return v;
}
__device__ __forceinline__ float wave_max(float v, int lane) {
#pragma unroll
    for (int o = 1; o < 64; o <<= 1) v = fmaxf(v, shx(v, o, lane));
    return v;
}
__device__ __forceinline__ float logsig(float x) { return fminf(x, 0.f) - __logf(1.f + __expf(-fabsf(x))); }
__device__ __forceinline__ int chunk_row(int b, int j) { return j < 2 ? ML + b * 256 + j * 128 : b * SEQ + (j - 2) * 128; }
#define FRESH_IDS() int tid = threadIdx.x; asm volatile("" : "+v"(tid)); const int lane = tid & 63, wave = __builtin_amdgcn_readfirstlane(tid >> 6); (void)lane; (void)wave
#define MFMA16(a, b, c) __builtin_amdgcn_mfma_f32_16x16x32_bf16((a), (b), (c), 0, 0, 0)

__device__ __forceinline__ void p0_transpose_item(const float* W, int K, int N, bf16* WT, int row_off, LAS float* scr, int item, int lane) {
    const int nblk = N / 32, kb = item / nblk, nb = item % nblk, k0 = 64 * kb, n0 = 32 * nb;
#pragma unroll 8
    for (int i = 0; i < 32; ++i) { const int kk = 2 * i + (lane >> 5); scr[kk * 33 + (lane & 31)] = W[(size_t)(k0 + kk) * N + n0 + (lane & 31)]; }
    asm volatile("s_waitcnt lgkmcnt(0)" ::: "memory");
    const int c = lane & 7;
#pragma unroll
    for (int j = 0; j < 4; ++j) { const int n = (lane >> 3) + 8 * j; const LAS float* s = scr + (8 * c) * 33 + n;
        v4u o; o.x = pk2(s[0 * 33], s[1 * 33]); o.y = pk2(s[2 * 33], s[3 * 33]); o.z = pk2(s[4 * 33], s[5 * 33]); o.w = pk2(s[6 * 33], s[7 * 33]);
        *(v4u*)(WT + (size_t)(row_off + n0 + n) * K + k0 + 8 * c) = o; }
    asm volatile("s_waitcnt lgkmcnt(0)" ::: "memory");
}

__device__ __forceinline__ void p0_transpose64(const float* W, int K, int N, bf16* WT, LAS unsigned char* scr, int item, int lane) {
    const int nblk = N >> 6, kb = item / nblk, nb = item - kb * nblk, k0 = 64 * kb, n0 = 64 * nb;
    const int n4 = lane & 15, kq = lane >> 4;
    const float* src = W + (size_t)(k0 + 16 * kq) * N + n0 + 4 * n4;
    f32x4 v[16];
#pragma unroll
    for (int i = 0; i < 16; ++i) v[i] = *(const f32x4*)(src + (size_t)i * N);
#pragma unroll
    for (int e = 0; e < 4; ++e) { v4u lo, hi;
        lo.x = pk2(v[0][e], v[1][e]); lo.y = pk2(v[2][e], v[3][e]); lo.z = pk2(v[4][e], v[5][e]); lo.w = pk2(v[6][e], v[7][e]);
        hi.x = pk2(v[8][e], v[9][e]); hi.y = pk2(v[10][e], v[11][e]); hi.z = pk2(v[12][e], v[13][e]); hi.w = pk2(v[14][e], v[15][e]);
        LAS unsigned char* d = scr + (4 * n4 + e) * 144 + 32 * kq;
        *(LAS v4u*)d = lo; *(LAS v4u*)(d + 16) = hi; }
    asm volatile("s_waitcnt lgkmcnt(0)" ::: "memory");
#pragma unroll
    for (int j = 0; j < 8; ++j) { const int c = lane + 64 * j, n = c >> 3, kc = c & 7;
        const v4u o = *(const LAS v4u*)(scr + n * 144 + 16 * kc);
        *(v4u*)(WT + (size_t)(n0 + n) * K + k0 + 8 * kc) = o; }
    asm volatile("s_waitcnt lgkmcnt(0)" ::: "memory");
}

__device__ __forceinline__ void phase_prologue(const Params& p, unsigned char* lds) {
    FRESH_IDS();
    unsigned char* ws = p.ws;
    const int G = gridDim.x, bx = blockIdx.x;
    {
        float* sv = (float*)lds; float* red = (float*)(lds + 12288);
        for (int i = tid; i < 3072; i += NTHR) { const int r = i >> 10, k = i & 1023; const float xv = r < 2 ? p.c[r * 1024 + k] : p.c_ctx[k]; sv[i] = xv / (1.f + expf(-xv)); }
        __syncthreads();
        float* mod = (float*)(ws + WS_MOD);
        for (int item = bx; item < 384; item += G) {
            const int l = item / 96, col0 = (item % 96) * 64, tx = tid & 15, kg = tid >> 4;
            const float* W = p.ada_w + (size_t)l * 1024 * 6144 + col0 + tx * 4;
            f32x4 a0 = (f32x4){0.f, 0.f, 0.f, 0.f}, a1 = a0, a2 = a0;
#pragma unroll 8
            for (int kk = 0; kk < 32; ++kk) { const int k = kg * 32 + kk; const f32x4 w = *(const f32x4*)(W + (size_t)k * 6144); a0 += w * sv[k]; a1 += w * sv[1024 + k]; a2 += w * sv[2048 + k]; }
#pragma unroll
            for (int e = 0; e < 4; ++e) { red[(kg * 3 + 0) * 64 + tx * 4 + e] = a0[e]; red[(kg * 3 + 1) * 64 + tx * 4 + e] = a1[e]; red[(kg * 3 + 2) * 64 + tx * 4 + e] = a2[e]; }
            __syncthreads();
            if (tid < 192) { const int r = tid >> 6, ci = tid & 63; float s = 0.f;
                for (int g = 0; g < 32; ++g) s += red[(g * 3 + r) * 64 + ci];
                mod[(l * 3 + r) * 6144 + col0 + ci] = s + p.ada_b[l * 6144 + col0 + ci]; }
            __syncthreads();
        }
    }
    {
        const int gi = bx * NTHR + tid;
        if (gi < 2048) { const int pos = gi >> 4, i = gi & 15;
            const float invf = exp2f(-(float)i * (13.287712379549449f / 16.f));
            const float ang = (float)pos * invf;
            const double rev = (double)ang * 0.15915494309189535; const double fr = rev - rint(rev);
            float* ct = (float*)(ws + WS_ROPE); float* st = ct + 2048;
            ct[gi] = __builtin_amdgcn_cosf((float)fr); st[gi] = __builtin_amdgcn_sinf((float)fr); }
    }
    {
        const size_t gt = (size_t)bx * NTHR + tid, GT = (size_t)G * NTHR;
        const f32x4* xs = (const f32x4*)p.x; f32x4* xd = (f32x4*)p.out;
        for (size_t i = gt; i < (size_t)ML * D / 4; i += GT) xd[i] = xs[i];
        const f32x4* cs = (const f32x4*)p.ctx; f32x4* cd = (f32x4*)(ws + WS_HC);
        for (size_t i = gt; i < (size_t)(MT - ML) * D / 4; i += GT) cd[i] = cs[i];
    }
    __syncthreads();
    {
        LAS unsigned char* scr = (LAS unsigned char*)lds + wave * 16384;
        const int gw = bx * NWAVES + wave, NGW = G * NWAVES;
        constexpr int I_UP = (D / 64) * (FF / 64), I_DN = (FF / 64) * (D / 64), I_AIN = (D / 64) * (3072 / 64), I_GATE = (D / 64), I_SQ = (D / 64) * (D / 64), I_BQ = (D / 64) * (1536 / 64);
        constexpr int NITEMS = 4 * I_UP + 4 * I_DN + 2 * I_AIN + 2 * I_GATE + 2 * I_SQ + I_BQ + I_SQ + I_AIN + I_SQ;
        for (int it = gw; it < NITEMS; it += NGW) {
            int r = it; const float* W; bf16* WT; int K = D, N = D; bool gate = false;
            if (r < 4 * I_UP) { const int l = r / I_UP; W = p.mlp_w1 + (size_t)l * D * FF; N = FF; WT = (bf16*)(ws + WS_W1) + (size_t)l * D * FF; r %= I_UP; }
            else if ((r -= 4 * I_UP) < 4 * I_DN) { const int l = r / I_DN; W = p.mlp_w2 + (size_t)l * D * FF; K = FF; WT = (bf16*)(ws + WS_W2) + (size_t)l * D * FF; r %= I_DN; }
            else if ((r -= 4 * I_DN) < 2 * I_AIN) { const int l = r / I_AIN; W = p.a_w_in + (size_t)l * D * 3072; N = 3072; WT = (bf16*)(ws + WS_AIN) + (size_t)l * 3328 * D; r %= I_AIN; }
            else if ((r -= 2 * I_AIN) < 2 * I_GATE) { const int l = r / I_GATE; W = p.a_w_gate + (size_t)l * D * 32; N = 32; WT = (bf16*)(ws + WS_AIN) + (size_t)l * 3328 * D; gate = true; r %= I_GATE; }
            else if ((r -= 2 * I_GATE) < 2 * I_SQ) { const int l = r / I_SQ; W = p.a_w_out + (size_t)l * D * D; WT = (bf16*)(ws + WS_AOUT) + (size_t)l * D * D; r %= I_SQ; }
            else if ((r -= 2 * I_SQ) < I_BQ) { W = p.b_w_qkv; N = 1536; WT = (bf16*)(ws + WS_BQKV); }
            else if ((r -= I_BQ) < I_SQ) { W = p.b_w_out; WT = (bf16*)(ws + WS_BOUT); }
            else if ((r -= I_SQ) < I_AIN) { W = p.c_w_in; N = 3072; WT = (bf16*)(ws + WS_CIN); }
            else { r -= I_AIN; W = p.c_w_out; WT = (bf16*)(ws + WS_COUT); }
            if (gate) p0_transpose_item(W, K, N, WT, 3072, (LAS float*)scr, r, lane);
            else p0_transpose64(W, K, N, WT, scr, r, lane);
        }
    }
}

__device__ __forceinline__ void phase_norm(const Params& p, int nrows, const float* g, const float* shift, const float* scale, int nparts) {
    FRESH_IDS();
    const int gw = blockIdx.x * NWAVES + wave, NGW = gridDim.x * NWAVES;
    float* hc = (float*)(p.ws + WS_HC); bf16* xn = (bf16*)(p.ws + WS_XN);
    for (int row0 = gw; row0 < nrows; row0 += 2 * NGW) {
        const int row1 = row0 + NGW; const bool has1 = row1 < nrows; const int rowb = has1 ? row1 : row0;
        const float* src0 = row0 < ML ? p.out + (size_t)row0 * D : hc + (size_t)(row0 - ML) * D;
        const float* src1 = rowb < ML ? p.out + (size_t)rowb * D : hc + (size_t)(rowb - ML) * D;
        const f32x4* xr0 = (const f32x4*)src0 + lane; const f32x4* xr1 = (const f32x4*)src1 + lane;
        f32x4 v0[4], v1[4]; float s0 = 0.f, s1 = 0.f;
#pragma unroll
        for (int j = 0; j < 4; ++j) { v0[j] = xr0[64 * j]; v1[j] = xr1[64 * j]; }
        if (nparts > 0) {
            const float* part = (const float*)(p.ws + WS_PART);
            if (row0 >= ML) { f32x4* hw = (f32x4*)(hc + (size_t)(row0 - ML) * D) + lane;
                for (int k = 0; k < nparts; ++k) { const f32x4* pr = (const f32x4*)(part + ((size_t)k * 512 + (row0 - ML)) * D) + lane;
#pragma unroll
                    for (int j = 0; j < 4; ++j) v0[j] += pr[64 * j]; }
#pragma unroll
                for (int j = 0; j < 4; ++j) hw[64 * j] = v0[j]; }
            if (has1 && row1 >= ML) { f32x4* hw = (f32x4*)(hc + (size_t)(row1 - ML) * D) + lane;
                for (int k = 0; k < nparts; ++k) { const f32x4* pr = (const f32x4*)(part + ((size_t)k * 512 + (row1 - ML)) * D) + lane;
#pragma unroll
                    for (int j = 0; j < 4; ++j) v1[j] += pr[64 * j]; }
#pragma unroll
                for (int j = 0; j < 4; ++j) hw[64 * j] = v1[j]; }
        }
#pragma unroll
        for (int j = 0; j < 4; ++j) { s0 += (v0[j].x * v0[j].x + v0[j].y * v0[j].y) + (v0[j].z * v0[j].z + v0[j].w * v0[j].w); s1 += (v1[j].x * v1[j].x + v1[j].y * v1[j].y) + (v1[j].z * v1[j].z + v1[j].w * v1[j].w); }
        const float rs0 = __builtin_amdgcn_rsqf(wave_sum(s0, lane) * (1.f / D) + 1e-6f), rs1 = __builtin_amdgcn_rsqf(wave_sum(s1, lane) * (1.f / D) + 1e-6f);
        const int r0 = row0 < ML ? (row0 >> 13) : 2, r1 = rowb < ML ? (rowb >> 13) : 2;
        unsigned long long* o0 = (unsigned long long*)(xn + (size_t)row0 * D) + lane; unsigned long long* o1 = (unsigned long long*)(xn + (size_t)rowb * D) + lane;
#pragma unroll
        for (int j = 0; j < 4; ++j) { const int col = 4 * lane + 256 * j;
            const f32x4 gg = *(const f32x4*)(g + col);
            { const f32x4 sh = *(const f32x4*)(shift + r0 * 6144 + col), sc = *(const f32x4*)(scale + r0 * 6144 + col);
              const f32x4 y = (v0[j] * rs0) * gg * (sc + 1.0f) + sh;
              o0[64 * j] = (unsigned long long)pk2(y.x, y.y) | ((unsigned long long)pk2(y.z, y.w) << 32); }
            if (has1) { const f32x4 sh = *(const f32x4*)(shift + r1 * 6144 + col), sc = *(const f32x4*)(scale + r1 * 6144 + col);
              const f32x4 y = (v1[j] * rs1) * gg * (sc + 1.0f) + sh;
              o1[64 * j] = (unsigned long long)pk2(y.x, y.y) | ((unsigned long long)pk2(y.z, y.w) << 32); }
        }
    }
}
__device__ __forceinline__ void phase_final_norm(const Params& p) {
    FRESH_IDS();
    const int gw = blockIdx.x * NWAVES + wave, NGW = gridDim.x * NWAVES;
    for (int row = gw; row < ML; row += NGW) {
        f32x4* xr = (f32x4*)(p.out + (size_t)row * D) + lane;
        f32x4 v[4]; float s = 0.f;
#pragma unroll
        for (int j = 0; j < 4; ++j) { v[j] = xr[64 * j]; s += (v[j].x * v[j].x + v[j].y * v[j].y) + (v[j].z * v[j].z + v[j].w * v[j].w); }
        const float rs = __builtin_amdgcn_rsqf(wave_sum(s, lane) * (1.f / D) + 1e-6f);
#pragma unroll
        for (int j = 0; j < 4; ++j) { const f32x4 gg = *(const f32x4*)(p.final_g + 4 * lane + 256 * j); xr[64 * j] = (v[j] * rs) * gg; }
    }
}

__device__ __forceinline__ void phase_conv(const Params& p, int nrows) {
    FRESH_IDS();
    const bf16* P = (const bf16*)(p.ws + WS_ACT); bf16* Z = (bf16*)(p.ws + WS_HG);
    const int gt = blockIdx.x * NTHR + tid, GT = gridDim.x * NTHR;
    const int ch = (gt & 127) * 8;
    f32x4 cw[3][2], cb[2];
#pragma unroll
    for (int h = 0; h < 2; ++h) { cb[h] = *(const f32x4*)(p.c_conv_b + ch + 4 * h);
#pragma unroll
        for (int w = 0; w < 3; ++w) cw[w][h] = *(const f32x4*)(p.c_conv_w + w * 1024 + ch + 4 * h); }
    for (int q = gt >> 7; q < nrows / 4; q += GT >> 7) {
        const int row0 = 4 * q;
        bool hp, hn;
        if (row0 < ML) { const int s0 = row0 & (SEQ - 1); hp = s0 > 0; hn = s0 + 4 < SEQ; } else { const int t0 = (row0 - ML) & (CTXL - 1); hp = t0 > 0; hn = t0 + 4 < CTXL; }
        const bf16* pr = P + (size_t)row0 * 3072 + ch;
        v4u cg[6], xt[6], bgv[4];
#pragma unroll
        for (int i = 0; i < 6; ++i) { const bool ok = (i == 0) ? hp : ((i == 5) ? hn : true);
            if (ok) { cg[i] = *(const v4u*)(pr + (ptrdiff_t)(i - 1) * 3072 + 1024); xt[i] = *(const v4u*)(pr + (ptrdiff_t)(i - 1) * 3072 + 2048); }
            else { cg[i] = (v4u){0u, 0u, 0u, 0u}; xt[i] = cg[i]; } }
#pragma unroll
        for (int i = 0; i < 4; ++i) bgv[i] = *(const v4u*)(pr + (size_t)i * 3072);
        float u[6][8];
#pragma unroll
        for (int i = 0; i < 6; ++i)
#pragma unroll
            for (int e2 = 0; e2 < 4; ++e2) { u[i][2 * e2] = bflo(cg[i][e2]) * bflo(xt[i][e2]); u[i][2 * e2 + 1] = bfhi(cg[i][e2]) * bfhi(xt[i][e2]); }
#pragma unroll
        for (int i = 0; i < 4; ++i) { v4u o;
#pragma unroll
            for (int e2 = 0; e2 < 4; ++e2) { const int e = 2 * e2, h = e >> 2, k = e & 3;
                const float a0 = cb[h][k] + cw[0][h][k] * u[i][e] + cw[1][h][k] * u[i + 1][e] + cw[2][h][k] * u[i + 2][e];
                const float a1 = cb[h][k + 1] + cw[0][h][k + 1] * u[i][e + 1] + cw[1][h][k + 1] * u[i + 1][e + 1] + cw[2][h][k + 1] * u[i + 2][e + 1];
                o[e2] = pk2(bflo(bgv[i][e2]) * a0, bfhi(bgv[i][e2]) * a1); }
            *(v4u*)(Z + (size_t)(row0 + i) * 1024 + ch) = o; }
    }
}

__device__ __forceinline__ void mlstm_scan(const float* lf, const float* li, float* bo, float* gso, float* mco, float mprev, bool bwd, int lane) {
    const int i0 = bwd ? 127 - 2 * lane : 2 * lane, i1 = bwd ? 126 - 2 * lane : 2 * lane + 1;
    const float a0 = lf[i0], a1 = lf[i1];
    float s = a0 + a1;
#pragma unroll
    for (int o = 1; o < 64; o <<= 1) { const float t = shup(s, o, lane); if (lane >= o) s += t; }
    const float b0 = s - a1, b1 = s;
    bo[i0] = b0; bo[i1] = b1;
    const float g0 = li[i0] - b0, g1 = li[i1] - b1;
    if (gso) { gso[i0] = g0; gso[i1] = g1; }
    if (mco) {
        float pm = fmaxf(g0, g1);
#pragma unroll
        for (int o = 1; o < 64; o <<= 1) { const float t = shup(pm, o, lane); if (lane >= o) pm = fmaxf(pm, t); }
        float pe = shup(pm, 1, lane); if (lane == 0) pe = NEG_BIG;
        const float m0 = fmaxf(pe, g0), m1 = fmaxf(m0, g1);
        mco[i0] = b0 + fmaxf(mprev, m0); mco[i1] = b1 + fmaxf(mprev, m1);
    }
}

__device__ __forceinline__ void phase_mlstm_local(const Params& p, unsigned char* lds) {
    FRESH_IDS();
    const bf16* P = (const bf16*)(p.ws + WS_ACT); const float* Gt = (const float*)(p.ws + WS_G);
    float* dC = (float*)(p.ws + WS_DC); float* dN = (float*)(p.ws + WS_DN);
    float* mloc = (float*)(p.ws + WS_MISC); float* bend = mloc + 32 * NCH;
    bf16* Vt = (bf16*)lds; bf16* Ktf = (bf16*)(lds + 34816); bf16* Ktb = (bf16*)(lds + 52224);
    float* fl = (float*)(lds + 69632);
    float *lif = fl, *lff = fl + 128, *lib = fl + 256, *lfb = fl + 384, *bfw = fl + 512, *bbw = fl + 640, *wsf = fl + 768, *wsb = fl + 896;
    const int fr = lane & 15, fq = lane >> 4;
    for (int item = blockIdx.x; item < NBATCH * 8 * NCH; item += gridDim.x) {
        int tix = tid; asm volatile("" : "+v"(tix));
        const int b = item / (8 * NCH), hd = (item / NCH) % 8, j = item % NCH;
        const int row0 = chunk_row(b, j);
        const int chain0 = (b * 8 + hd) * 2;
        int ll = tix & 63; const int fr = ll & 15, fq = ll >> 4;
        __syncthreads();
        if (tix < 128) { const float* g = Gt + (size_t)(row0 + tix) * 32; lif[tix] = g[hd]; lff[tix] = logsig(g[8 + hd]); lib[tix] = g[16 + hd]; lfb[tix] = logsig(g[24 + hd]); }
        __syncthreads();
        if (wave < 2) {
            const bool bw = wave == 1;
            mlstm_scan(bw ? lfb : lff, bw ? lib : lif, bw ? bbw : bfw, nullptr, nullptr, 0.f, bw, lane);
            asm volatile("s_waitcnt lgkmcnt(0)" ::: "memory");
            const float* bb_ = bw ? bbw : bfw; const float* li_ = bw ? lib : lif; float* ws_ = bw ? wsb : wsf;
            const float be = bw ? bb_[0] : bb_[127];
            const float w0 = be - bb_[lane] + li_[lane], w1 = be - bb_[lane + 64] + li_[lane + 64];
            const float mx = wave_max(fmaxf(w0, w1), lane);
            ws_[lane] = __expf(w0 - mx); ws_[lane + 64] = __expf(w1 - mx);
            if (lane == 0) { mloc[(chain0 + wave) * NCH + j] = mx; bend[(chain0 + wave) * NCH + j] = be; }
        }
        __syncthreads();
        for (int c = tix; c < 2048; c += NTHR) { const int s = c & 127, ch = c >> 7;
            const v4u v = *(const v4u*)(P + (size_t)(row0 + s) * 3072 + 1024 + hd * 128 + ch * 8);
#pragma unroll
            for (int e2 = 0; e2 < 4; ++e2) { Vt[(ch * 8 + 2 * e2) * 136 + s] = (bf16)(v[e2] & 0xffffu); Vt[(ch * 8 + 2 * e2 + 1) * 136 + s] = (bf16)(v[e2] >> 16); } }
        for (int c = tix; c < 1024; c += NTHR) { const int s = c & 127, ch = c >> 7;
            const v4u v = *(const v4u*)(P + (size_t)(row0 + s) * 3072 + 512 + hd * 64 + ch * 8);
            const float wf = wsf[s], wb = wsb[s];
#pragma unroll
            for (int e2 = 0; e2 < 4; ++e2) { const float k0 = bflo(v[e2]), k1 = bfhi(v[e2]);
                const unsigned pf_ = pk2(k0 * wf, k1 * wf), pb_ = pk2(k0 * wb, k1 * wb);
                Ktf[(ch * 8 + 2 * e2) * 136 + s] = (bf16)(pf_ & 0xffffu); Ktf[(ch * 8 + 2 * e2 + 1) * 136 + s] = (bf16)(pf_ >> 16);
                Ktb[(ch * 8 + 2 * e2) * 136 + s] = (bf16)(pb_ & 0xffffu); Ktb[(ch * 8 + 2 * e2 + 1) * 136 + s] = (bf16)(pb_ >> 16); } }
        __syncthreads();
#pragma unroll
        for (int dir = 0; dir < 2; ++dir) {
            const bf16* Kt = dir ? Ktb : Ktf;
            f32x4 acc[4];
#pragma unroll
            for (int nt = 0; nt < 4; ++nt) acc[nt] = (f32x4){0.f, 0.f, 0.f, 0.f};
#pragma unroll
            for (int ks = 0; ks < 4; ++ks) { const bf16x8 a = *(const bf16x8*)(Vt + (16 * wave + fr) * 136 + 32 * ks + 8 * fq);
#pragma unroll
                for (int nt = 0; nt < 4; ++nt) { const bf16x8 bb = *(const bf16x8*)(Kt + (16 * nt + fr) * 136 + 32 * ks + 8 * fq); acc[nt] = MFMA16(a, bb, acc[nt]); } }
            float* dst = dC + ((size_t)(chain0 + dir) * NCH + j) * 8192;
#pragma unroll
            for (int nt = 0; nt < 4; ++nt)
#pragma unroll
                for (int r = 0; r < 4; ++r) dst[(16 * wave + 4 * fq + r) * 64 + 16 * nt + fr] = acc[nt][r];
        }
        if (tix < 128) { const int dir = tix >> 6, dk = tix & 63; const bf16* Kt = (dir ? Ktb : Ktf) + dk * 136; float s = 0.f;
            for (int i = 0; i < 128; ++i) s += bf2f(Kt[i]);
            dN[((size_t)(chain0 + dir) * NCH + j) * 64 + dk] = s; }
    }
}

__device__ __forceinline__ void phase_mlstm_scan(const Params& p) {
    FRESH_IDS();
    const float* dC = (const float*)(p.ws + WS_DC); float* dN = (float*)(p.ws + WS_DN); unsigned* CP = (unsigned*)(p.ws + WS_CP);
    const float* mloc = (const float*)(p.ws + WS_MISC); const float* bend = mloc + 32 * NCH; float* mprev = (float*)(p.ws + WS_MISC) + 2 * 32 * NCH;
    const int GT = gridDim.x * NTHR;
    for (int idx = blockIdx.x * NTHR + tid; idx < 32 * 4096; idx += GT) {
        const int chain = idx >> 12, e = idx & 4095, dir = chain & 1;
        const float2* src = (const float2*)(dC + (size_t)chain * NCH * 8192) + e;
        unsigned* dst = CP + (size_t)chain * NCH * 4096 + e;
        float2* nsrc = (float2*)(dN + (size_t)chain * NCH * 64) + e;
        const bool don = e < 32;
        float zz = 0.f; asm volatile("" : "+v"(zz));
        float m = NEG_BIG; float2 C = make_float2(zz, zz), n = make_float2(zz, zz);
        for (int pb = 0; pb < NCH; pb += 11) {
            float2 xv[11], nv[11]; float ml[11], be[11];
#pragma unroll
            for (int u = 0; u < 11; ++u) { const int pp = pb + u; const int j = dir ? (pp < 2 ? 1 - pp : 67 - pp) : pp;
                xv[u] = src[(size_t)j * 4096]; ml[u] = mloc[chain * NCH + j]; be[u] = bend[chain * NCH + j];
                nv[u] = don ? nsrc[j * 32] : make_float2(0.f, 0.f); }
#pragma unroll
            for (int u = 0; u < 11; ++u) { const int pp = pb + u; const int j = dir ? (pp < 2 ? 1 - pp : 67 - pp) : pp;
                dst[(size_t)j * 4096] = pk2(C.x, C.y);
                if (don) nsrc[j * 32] = n;
                if (e == 0) mprev[chain * NCH + j] = m;
                const float mn = fmaxf(be[u] + m, ml[u]);
                const float dcy = __expf(be[u] + m - mn), w = __expf(ml[u] - mn);
                C.x = dcy * C.x + w * xv[u].x; C.y = dcy * C.y + w * xv[u].y;
                n.x = dcy * n.x + w * nv[u].x; n.y = dcy * n.y + w * nv[u].y;
                m = mn; }
        }
    }
}

__device__ __forceinline__ void phase_mlstm_out(const Params& p, unsigned char* lds, int lyr_a, bool ctx_out) {
    FRESH_IDS();
    const bf16* P = (const bf16*)(p.ws + WS_ACT); const float* Gt = (const float*)(p.ws + WS_G);
    const float* nP = (const float*)(p.ws + WS_DN); const bf16* CP = (const bf16*)(p.ws + WS_CP);
    const float* mprev = (const float*)(p.ws + WS_MISC) + 2 * 32 * NCH;
    const float* head_g = p.a_head_g + lyr_a * 1024;
    bf16* HG = (bf16*)(p.ws + WS_HG);
    bf16* Qs = (bf16*)lds; bf16* Ks = (bf16*)(lds + 18432); bf16* Vt = (bf16*)(lds + 36864); bf16* Ct = (bf16*)(lds + 71680);
    float* fl = (float*)(lds + 106496);
    float *bfw = fl, *bbw = fl + 128, *gsf = fl + 256, *gsb = fl + 384, *mcf = fl + 512, *mcb = fl + 640, *lif = fl + 768, *lff = fl + 896, *lib = fl + 1024, *lfb = fl + 1152, *nf = fl + 1280, *nb = fl + 1344;
    const int fr = lane & 15, fq = lane >> 4;
    const int jlo = ctx_out ? 0 : 2, nj = NCH - jlo;
    const int nitems = NBATCH * 8 * nj;
    v4u rq[2], rk[2], rv[4], rc[4]; float rg0 = 0.f, rg1 = 0.f, rg2 = 0.f, rg3 = 0.f, rn = 0.f, rmf = 0.f, rmb = 0.f;
#define P5_PREFETCH(it_) do { const int b_ = (it_) / (8 * nj), hd_ = ((it_) / nj) % 8, j_ = jlo + (it_) % nj; const int row0_ = chunk_row(b_, j_), chain0_ = (b_ * 8 + hd_) * 2; \
        rmf = mprev[(chain0_ + 0) * NCH + j_]; rmb = mprev[(chain0_ + 1) * NCH + j_]; \
        if (tix < 128) { const float* g_ = Gt + (size_t)(row0_ + tix) * 32; rg0 = g_[hd_]; rg1 = g_[8 + hd_]; rg2 = g_[16 + hd_]; rg3 = g_[24 + hd_]; \
            rn = nP[((size_t)(chain0_ + (tix >> 6)) * NCH + j_) * 64 + (tix & 63)]; } \
        _Pragma("unroll") for (int i = 0; i < 2; ++i) { const int c = tix + i * NTHR, r = c >> 3, ch = c & 7; \
            rq[i] = *(const v4u*)(P + (size_t)(row0_ + r) * 3072 + hd_ * 64 + ch * 8); rk[i] = *(const v4u*)(P + (size_t)(row0_ + r) * 3072 + 512 + hd_ * 64 + ch * 8); } \
        _Pragma("unroll") for (int i = 0; i < 4; ++i) { const int c = tix + i * NTHR; \
            rv[i] = *(const v4u*)(P + (size_t)(row0_ + (c & 127)) * 3072 + 1024 + hd_ * 128 + (c >> 7) * 8); \
            rc[i] = *(const v4u*)(CP + ((size_t)(chain0_ + (c >> 10)) * NCH + j_) * 8192 + ((c >> 3) & 127) * 64 + (c & 7) * 8); } } while (0)
    { int tix = tid; asm volatile("" : "+v"(tix)); if ((int)blockIdx.x < nitems) P5_PREFETCH((int)blockIdx.x); }
    for (int item = blockIdx.x; item < nitems; item += gridDim.x) {
        int tix = tid; asm volatile("" : "+v"(tix));
        const int b = item / (8 * nj), hd = (item / nj) % 8, j = jlo + item % nj;
        const int row0 = chunk_row(b, j);
        const int chain0 = (b * 8 + hd) * 2;
        int ll = tix & 63; const int fr = ll & 15, fq = ll >> 4;
        const float m_f = rmf, m_b = rmb;
        asm volatile("s_waitcnt lgkmcnt(0)" ::: "memory"); __builtin_amdgcn_s_barrier(); asm volatile("" ::: "memory");
        if (tix < 128) { lif[tix] = rg0; lff[tix] = logsig(rg1); lib[tix] = rg2; lfb[tix] = logsig(rg3); ((tix >> 6) ? nb : nf)[tix & 63] = rn; }
#pragma unroll
        for (int i = 0; i < 2; ++i) { const int c = tix + i * NTHR, r = c >> 3, ch = c & 7;
            *(v4u*)(Qs + r * 72 + ch * 8) = rq[i]; *(v4u*)(Ks + r * 72 + ch * 8) = rk[i]; }
#pragma unroll
        for (int i = 0; i < 4; ++i) { const int c = tix + i * NTHR; const int s = c & 127, ch = c >> 7; const v4u v = rv[i];
#pragma unroll
            for (int e2 = 0; e2 < 4; ++e2) { Vt[(ch * 8 + 2 * e2) * 136 + s] = (bf16)(v[e2] & 0xffffu); Vt[(ch * 8 + 2 * e2 + 1) * 136 + s] = (bf16)(v[e2] >> 16); }
            const int dir = c >> 10, dv = (c >> 3) & 127, ch2 = c & 7;
            *(v4u*)(Ct + dv * 136 + dir * 64 + ch2 * 8) = rc[i]; }
        asm volatile("s_waitcnt lgkmcnt(0)" ::: "memory"); __builtin_amdgcn_s_barrier(); asm volatile("" ::: "memory");
        if (wave == 0) mlstm_scan(lff, lif, bfw, gsf, mcf, m_f, false, lane);
        else if (wave == 1) mlstm_scan(lfb, lib, bbw, gsb, mcb, m_b, true, lane);
        asm volatile("s_waitcnt lgkmcnt(0)" ::: "memory"); __builtin_amdgcn_s_barrier(); asm volatile("" ::: "memory");
        if (item + (int)gridDim.x < nitems) P5_PREFETCH(item + (int)gridDim.x);
        const int t = 16 * wave + fr;
        const float btf = bfw[t], mcft = mcf[t], btb = bbw[t], mcbt = mcb[t];
        const float af = __expf(btf + m_f - mcft), ab = __expf(btb + m_b - mcbt);
        float qnf = 0.f, qnb = 0.f;
#pragma unroll
        for (int i = 0; i < 16; ++i) { const int dk = 16 * fq + i; const float qv = bf2f(Qs[t * 72 + dk]); qnf += qv * nf[dk]; qnb += qv * nb[dk]; }
        qnf += shx(qnf, 16, ll); qnf += shx(qnf, 32, ll); qnb += shx(qnb, 16, ll); qnb += shx(qnb, 32, ll);
        qnf *= 0.125f; qnb *= 0.125f;
        bf16x8 bq[2];
#pragma unroll
        for (int ks = 0; ks < 2; ++ks) bq[ks] = *(const bf16x8*)(Qs + t * 72 + 32 * ks + 8 * fq);
        f32x4 scf[8], scb[8]; float sumf = 0.f, sumb = 0.f;
#pragma unroll
        for (int st = 0; st < 8; ++st) {
            f32x4 acc = (f32x4){0.f, 0.f, 0.f, 0.f};
#pragma unroll
            for (int ks = 0; ks < 2; ++ks) { const bf16x8 a = *(const bf16x8*)(Ks + (16 * st + fr) * 72 + 32 * ks + 8 * fq); acc = MFMA16(a, bq[ks], acc); }
            const f32x4 gf4 = *(const f32x4*)(gsf + 16 * st + 4 * fq), gb4 = *(const f32x4*)(gsb + 16 * st + 4 * fq);
#pragma unroll
            for (int r = 0; r < 4; ++r) { const int s = 16 * st + 4 * fq + r; const float sv = acc[r] * 0.125f;
                const float df = (s <= t) ? __expf(btf + gf4[r] - mcft) : 0.f, db = (s >= t) ? __expf(btb + gb4[r] - mcbt) : 0.f;
                scf[st][r] = sv * df; scb[st][r] = sv * db; sumf += scf[st][r]; sumb += scb[st][r]; }
        }
        sumf += shx(sumf, 16, ll); sumf += shx(sumf, 32, ll); sumb += shx(sumb, 16, ll); sumb += shx(sumb, 32, ll);
        const float rf = __builtin_amdgcn_rcpf(fmaxf(fabsf(sumf + af * qnf), __expf(-mcft))), rb = __builtin_amdgcn_rcpf(fmaxf(fabsf(sumb + ab * qnb), __expf(-mcbt)));
        bf16x8 pf[4], qf[4];
#pragma unroll
        for (int kp = 0; kp < 4; ++kp) { v4u w;
            w.x = pk2(scf[2 * kp][0] * rf + scb[2 * kp][0] * rb, scf[2 * kp][1] * rf + scb[2 * kp][1] * rb);
            w.y = pk2(scf[2 * kp][2] * rf + scb[2 * kp][2] * rb, scf[2 * kp][3] * rf + scb[2 * kp][3] * rb);
            w.z = pk2(scf[2 * kp + 1][0] * rf + scb[2 * kp + 1][0] * rb, scf[2 * kp + 1][1] * rf + scb[2 * kp + 1][1] * rb);
            w.w = pk2(scf[2 * kp + 1][2] * rf + scb[2 * kp + 1][2] * rb, scf[2 * kp + 1][3] * rf + scb[2 * kp + 1][3] * rb);
            pf[kp] = __builtin_bit_cast(bf16x8, w); }
#pragma unroll
        for (int ks = 0; ks < 4; ++ks) { const float scl = 0.125f * ((ks >> 1) ? ab * rb : af * rf);
            const v4u qr = *(const v4u*)(Qs + t * 72 + 32 * (ks & 1) + 8 * fq); v4u w;
#pragma unroll
            for (int e2 = 0; e2 < 4; ++e2) w[e2] = pk2(bflo(qr[e2]) * scl, bfhi(qr[e2]) * scl);
            qf[ks] = __builtin_bit_cast(bf16x8, w); }
        const size_t row = (size_t)(row0 + t);
        v2u ovp[8];
#pragma unroll
        for (int dt = 0; dt < 8; ++dt) ovp[dt] = *(const v2u*)(P + row * 3072 + 2048 + hd * 128 + 16 * dt + 4 * fq);
        f32x4 hacc[8]; float ss = 0.f;
#pragma unroll
        for (int dt = 0; dt < 8; ++dt) {
            f32x4 acc = (f32x4){0.f, 0.f, 0.f, 0.f};
#pragma unroll
            for (int kp = 0; kp < 4; ++kp) { v4u aw; const v2u lo = *(const v2u*)(Vt + (16 * dt + fr) * 136 + 32 * kp + 4 * fq), hi = *(const v2u*)(Vt + (16 * dt + fr) * 136 + 32 * kp + 16 + 4 * fq);
                aw.x = lo.x; aw.y = lo.y; aw.z = hi.x; aw.w = hi.y; acc = MFMA16(__builtin_bit_cast(bf16x8, aw), pf[kp], acc); }
#pragma unroll
            for (int ks = 0; ks < 4; ++ks) { const bf16x8 a = *(const bf16x8*)(Ct + (16 * dt + fr) * 136 + 32 * ks + 8 * fq); acc = MFMA16(a, qf[ks], acc); }
            hacc[dt] = acc; ss += (acc[0] * acc[0] + acc[1] * acc[1]) + (acc[2] * acc[2] + acc[3] * acc[3]);
        }
        ss += shx(ss, 16, ll); ss += shx(ss, 32, ll);
        const float rn = __builtin_amdgcn_rsqf(ss * (1.f / 128.f) + 1e-6f);
#pragma unroll
        for (int dt = 0; dt < 8; ++dt) { const int dv0 = 16 * dt + 4 * fq;
            const v2u ov = ovp[dt]; const f32x4 hg4 = *(const f32x4*)(head_g + hd * 128 + dv0);
            const float o0 = bflo(ov.x), o1 = bfhi(ov.x), o2 = bflo(ov.y), o3 = bfhi(ov.y);
            const float y0 = hacc[dt][0] * rn * hg4[0] * __builtin_amdgcn_rcpf(1.f + __expf(-o0)), y1 = hacc[dt][1] * rn * hg4[1] * __builtin_amdgcn_rcpf(1.f + __expf(-o1));
            const float y2 = hacc[dt][2] * rn * hg4[2] * __builtin_amdgcn_rcpf(1.f + __expf(-o2)), y3 = hacc[dt][3] * rn * hg4[3] * __builtin_amdgcn_rcpf(1.f + __expf(-o3));
            v2u w; w.x = pk2(y0, y1); w.y = pk2(y2, y3);
            *(v2u*)(HG + row * 1024 + hd * 128 + dv0) = w; }
    }
}

#undef P5_PREFETCH
__device__ __forceinline__ void phase_attn(const Params& p, unsigned char* lds, bool ctx_out) {
    FRESH_IDS();
    const bf16* Pq = (const bf16*)(p.ws + WS_ACT); bf16* AO = (bf16*)(p.ws + WS_HG);
    bf16* Ks = (bf16*)lds; bf16* Vt = (bf16*)(lds + 18432);
    const int fr = lane & 15, fq = lane >> 4;
    const int nitems = 512 + (ctx_out ? 16 : 0);
    const int vb0 = ((int)gridDim.x & 7) == 0 ? ((int)blockIdx.x & 7) * ((int)gridDim.x >> 3) + ((int)blockIdx.x >> 3) : (int)blockIdx.x;
    for (int item = vb0; item < nitems; item += gridDim.x) {
        int tix = tid; asm volatile("" : "+v"(tix));
        int b, g, qrow0, nblk = 0; bool lat = item < 512;
        if (lat) { b = item >> 8; g = (item >> 6) & 3; nblk = item & 63; qrow0 = b * SEQ + nblk * 128; }
        else { const int ci = item - 512; b = ci >> 3; g = (ci >> 1) & 3; qrow0 = ML + b * CTXL + (ci & 1) * 128; }
        const int hq = g * 4 + (wave >> 1), tbase = (wave & 1) * 64;
        const float sink = p.b_sinks[hq] * 1.4426950408889634f;
        unsigned char* Qw = lds + 36864 + wave * 8192;
        { const int l0 = tix & 63, fr0 = l0 & 15, fq0 = l0 >> 4;
#pragma unroll
          for (int tt = 0; tt < 4; ++tt)
#pragma unroll
              for (int ks = 0; ks < 2; ++ks) *(v4u*)(Qw + ((tt * 2 + ks) * 64 + l0) * 16) = *(const v4u*)(Pq + (size_t)(qrow0 + tbase + 16 * tt + fr0) * 1536 + hq * 64 + 32 * ks + 8 * fq0); }
        float mrun[4], lrun[4]; f32x4 oacc[4][4];
#pragma unroll
        for (int tt = 0; tt < 4; ++tt) { mrun[tt] = sink; lrun[tt] = (fq == 0) ? 1.f : 0.f;
#pragma unroll
            for (int dt = 0; dt < 4; ++dt) oacc[tt][dt] = (f32x4){0.f, 0.f, 0.f, 0.f}; }
        for (int c = 0; c < 5; ++c) {
            int krow0, mtype = 0;
            if (lat) {
                if (c == 0) { if (nblk == 0) continue; krow0 = qrow0 - 128; mtype = 1; }
                else if (c == 1) { krow0 = qrow0; }
                else if (c == 2) { if (nblk == 63) continue; krow0 = qrow0 + 128; mtype = 2; }
                else { krow0 = ML + b * CTXL + (c - 3) * 128; }
            } else { if (c < 3) continue; krow0 = ML + b * CTXL + (c - 3) * 128; }
            __syncthreads();
            int ll = tix & 63; asm volatile("" : "+v"(ll)); const int fr = ll & 15, fq = ll >> 4;
            for (int cc = tix; cc < 1024; cc += NTHR) { const int r = cc >> 3, ch = cc & 7;
                *(v4u*)(Ks + r * 72 + ch * 8) = *(const v4u*)(Pq + (size_t)(krow0 + r) * 1536 + 1024 + g * 64 + ch * 8); }
            for (int cc = tix; cc < 1024; cc += NTHR) { const int s = cc & 127, ch = cc >> 7;
                const v4u v = *(const v4u*)(Pq + (size_t)(krow0 + s) * 1536 + 1280 + g * 64 + ch * 8);
#pragma unroll
                for (int e2 = 0; e2 < 4; ++e2) { Vt[(ch * 8 + 2 * e2) * 136 + s] = (bf16)(v[e2] & 0xffffu); Vt[(ch * 8 + 2 * e2 + 1) * 136 + s] = (bf16)(v[e2] >> 16); } }
            __syncthreads();
#pragma unroll
            for (int tp = 0; tp < 2; ++tp) {
                bf16x8 bq[2][2]; f32x4 sa[2][8]; float mx[2] = {NEG_BIG, NEG_BIG};
#pragma unroll
                for (int h = 0; h < 2; ++h)
#pragma unroll
                    for (int ks = 0; ks < 2; ++ks) bq[h][ks] = *(const bf16x8*)(Qw + (((2 * tp + h) * 2 + ks) * 64 + ll) * 16);
#pragma unroll
                for (int st = 0; st < 8; ++st) {
                    bool dead[2];
#pragma unroll
                    for (int h = 0; h < 2; ++h) { const int q0 = tbase + 16 * (2 * tp + h); dead[h] = (mtype == 1) ? (16 * st + 15 < q0) : ((mtype == 2) ? (16 * st > q0 + 15) : false); }
                    if (dead[0] && dead[1]) { sa[0][st] = (f32x4){NEG_BIG, NEG_BIG, NEG_BIG, NEG_BIG}; sa[1][st] = sa[0][st]; continue; }
                    bf16x8 kf[2];
#pragma unroll
                    for (int ks = 0; ks < 2; ++ks) kf[ks] = *(const bf16x8*)(Ks + (16 * st + fr) * 72 + 32 * ks + 8 * fq);
#pragma unroll
                    for (int h = 0; h < 2; ++h) {
                        if (dead[h]) { sa[h][st] = (f32x4){NEG_BIG, NEG_BIG, NEG_BIG, NEG_BIG}; continue; }
                        f32x4 acc = (f32x4){0.f, 0.f, 0.f, 0.f};
#pragma unroll
                        for (int ks = 0; ks < 2; ++ks) acc = MFMA16(kf[ks], bq[h][ks], acc);
                        if (mtype != 0) { const int t = tbase + 16 * (2 * tp + h) + fr;
#pragma unroll
                            for (int r = 0; r < 4; ++r) { const int d = (16 * st + 4 * fq + r) - t;
                                const bool ok = (mtype == 1) ? (d >= 0) : (d <= 0);
                                acc[r] = ok ? acc[r] : NEG_BIG; } }
                        mx[h] = fmaxf(fmaxf(mx[h], fmaxf(acc[0], acc[1])), fmaxf(acc[2], acc[3]));
                        sa[h][st] = acc;
                    }
                }
                bf16x8 pf[2][4]; float alpha[2];
#pragma unroll
                for (int h = 0; h < 2; ++h) { const int tt = 2 * tp + h;
                    float m_ = mx[h]; m_ = fmaxf(m_, shx(m_, 16, ll)); m_ = fmaxf(m_, shx(m_, 32, ll));
                    const float mn = fmaxf(mrun[tt], m_); alpha[h] = __builtin_amdgcn_exp2f(mrun[tt] - mn);
                    float ls = 0.f;
#pragma unroll
                    for (int st = 0; st < 8; ++st) {
                        const int q0 = tbase + 16 * tt;
                        const bool dead_ = (mtype == 1) ? (16 * st + 15 < q0) : ((mtype == 2) ? (16 * st > q0 + 15) : false);
                        if (dead_) { sa[h][st] = (f32x4){0.f, 0.f, 0.f, 0.f}; continue; }
#pragma unroll
                        for (int r = 0; r < 4; ++r) { const float pv = __builtin_amdgcn_exp2f(sa[h][st][r] - mn); sa[h][st][r] = pv; ls += pv; } }
                    lrun[tt] = lrun[tt] * alpha[h] + ls; mrun[tt] = mn;
#pragma unroll
                    for (int kp = 0; kp < 4; ++kp) { v4u w; w.x = pk2(sa[h][2 * kp][0], sa[h][2 * kp][1]); w.y = pk2(sa[h][2 * kp][2], sa[h][2 * kp][3]); w.z = pk2(sa[h][2 * kp + 1][0], sa[h][2 * kp + 1][1]); w.w = pk2(sa[h][2 * kp + 1][2], sa[h][2 * kp + 1][3]);
                        pf[h][kp] = __builtin_bit_cast(bf16x8, w); }
                }
#pragma unroll
                for (int dt = 0; dt < 4; ++dt) { f32x4 acc0 = oacc[2 * tp][dt] * alpha[0], acc1 = oacc[2 * tp + 1][dt] * alpha[1];
#pragma unroll
                    for (int kp = 0; kp < 4; ++kp) { v4u aw; const v2u lo = *(const v2u*)(Vt + (16 * dt + fr) * 136 + 32 * kp + 4 * fq), hi = *(const v2u*)(Vt + (16 * dt + fr) * 136 + 32 * kp + 16 + 4 * fq);
                        aw.x = lo.x; aw.y = lo.y; aw.z = hi.x; aw.w = hi.y; const bf16x8 vf = __builtin_bit_cast(bf16x8, aw);
                        acc0 = MFMA16(vf, pf[0][kp], acc0); acc1 = MFMA16(vf, pf[1][kp], acc1); }
                    oacc[2 * tp][dt] = acc0; oacc[2 * tp + 1][dt] = acc1; }
                __builtin_amdgcn_sched_barrier(0);
            }
        }
#pragma unroll
        for (int tt = 0; tt < 4; ++tt) { float lt = lrun[tt]; lt += shx(lt, 16, (tix & 63)); lt += shx(lt, 32, (tix & 63)); const float inv = 1.0f / lt;
            const size_t row = (size_t)(qrow0 + tbase + 16 * tt + fr);
#pragma unroll
            for (int dt = 0; dt < 4; ++dt) { v2u w; w.x = pk2(oacc[tt][dt][0] * inv, oacc[tt][dt][1] * inv); w.y = pk2(oacc[tt][dt][2] * inv, oacc[tt][dt][3] * inv);
                *(v2u*)(AO + row * 1024 + hq * 64 + 16 * dt + 4 * fq) = w; } }
    }
}


__device__ __forceinline__ void ctx_norm_part(const Params& p, const float* g, const float* shift, const float* scale, int nparts, unsigned* ctr) {
    FRESH_IDS();
    if (blockIdx.x < 64) {
        const int row = blockIdx.x * 8 + wave;
        float* hrow = (float*)(p.ws + WS_HC) + (size_t)row * D; bf16* xn = (bf16*)(p.ws + WS_XN) + (size_t)(ML + row) * D;
        const float* part = (const float*)(p.ws + WS_PART);
        f32x4* xr = (f32x4*)hrow + lane; f32x4 v[4];
#pragma unroll
        for (int j = 0; j < 4; ++j) v[j] = xr[64 * j];
        for (int k = 0; k < nparts; ++k) { const f32x4* pr = (const f32x4*)(part + ((size_t)k * 512 + row) * D) + lane;
#pragma unroll
            for (int j = 0; j < 4; ++j) v[j] += pr[64 * j]; }
        float s = 0.f;
#pragma unroll
        for (int j = 0; j < 4; ++j) { if (nparts > 0) xr[64 * j] = v[j]; s += (v[j].x * v[j].x + v[j].y * v[j].y) + (v[j].z * v[j].z + v[j].w * v[j].w); }
        const float rs = __builtin_amdgcn_rsqf(wave_sum(s, lane) * (1.f / D) + 1e-6f);
        unsigned long long* o8 = (unsigned long long*)xn + lane;
#pragma unroll
        for (int j = 0; j < 4; ++j) { const int col = 4 * lane + 256 * j;
            const f32x4 gg = *(const f32x4*)(g + col), sh = *(const f32x4*)(shift + 2 * 6144 + col), sc = *(const f32x4*)(scale + 2 * 6144 + col);
            const f32x4 y = (v[j] * rs) * gg * (sc + 1.0f) + sh;
            o8[64 * j] = (unsigned long long)pk2(y.x, y.y) | ((unsigned long long)pk2(y.z, y.w) << 32); }
        asm volatile("s_waitcnt vmcnt(0)" ::: "memory");
        __syncthreads();
        if (tid == 0) { __builtin_amdgcn_fence(__ATOMIC_RELEASE, "agent"); asm volatile("s_waitcnt vmcnt(0)" ::: "memory"); __hip_atomic_fetch_add(ctr, 1u, __ATOMIC_RELAXED, __HIP_MEMORY_SCOPE_AGENT); }
    }
}
__device__ __forceinline__ void ctx_wait(unsigned* ctr) {
    if (threadIdx.x == 0) { unsigned sp = 0;
        while (__hip_atomic_load(ctr, __ATOMIC_RELAXED, __HIP_MEMORY_SCOPE_AGENT) < 64u) { __builtin_amdgcn_s_sleep(2); if (++sp > (1u << 22)) break; }
        __builtin_amdgcn_fence(__ATOMIC_ACQUIRE, "agent"); asm volatile("s_waitcnt vmcnt(0)" ::: "memory"); }
    __syncthreads();
}

template <int MODE>
__device__ __forceinline__ void ctx_gemm(unsigned char* lds, const bf16* A, const bf16* Bt, int N, int K, int ksplit, bf16* Ob, int ldo, float* Of, const float* vec, float scale0, int scale_cols, unsigned* waitctr,
                                         int row_base = ML, int mtiles = 4, bool fromfront = false) {
    FRESH_IDS();
    const int fr = lane & 15, fq = lane >> 4, G = gridDim.x, bx = blockIdx.x;
    const int ntn = (N + 63) >> 6, ntiles = mtiles * ntn * ksplit, Kp = K / ksplit;
    const int tfirst = fromfront ? bx : G - 1 - bx;
    bf16* As = (bf16*)lds; bf16* Bs = (bf16*)(lds + 67584);
    if (waitctr != nullptr && tfirst < ntiles) ctx_wait(waitctr);
    for (int t = tfirst; t < ntiles; t += G) {
        const int ks = t % ksplit, r = t / ksplit, mt = r % mtiles, ntl = r / mtiles;
        const int n0 = ntl * 64, k0 = ks * Kp;
        const int m0 = mt * 128 + wave * 16;
        const bf16* ag = A + (size_t)(mt * 128 + (tid >> 5)) * K + k0 + 8 * (tid & 31);
        const bf16* bg = Bt + (size_t)(n0 + (tid >> 5)) * K + k0 + 8 * (tid & 31);
        f32x4 acc[4];
#pragma unroll
        for (int nt = 0; nt < 4; ++nt) acc[nt] = (f32x4){0.f, 0.f, 0.f, 0.f};
        v4u ra[8], rb[4];
#pragma unroll
        for (int i = 0; i < 8; ++i) ra[i] = *(const v4u*)(ag + (size_t)i * 16 * K);
#pragma unroll
        for (int i = 0; i < 4; ++i) rb[i] = *(const v4u*)(bg + (size_t)i * 16 * K);
        for (int kk = 0; kk < Kp; kk += 256) {
            __syncthreads();
#pragma unroll
            for (int i = 0; i < 8; ++i) *(v4u*)(As + ((tid >> 5) + 16 * i) * 264 + 8 * (tid & 31)) = ra[i];
#pragma unroll
            for (int i = 0; i < 4; ++i) *(v4u*)(Bs + ((tid >> 5) + 16 * i) * 264 + 8 * (tid & 31)) = rb[i];
            __syncthreads();
            if (kk + 256 < Kp) {
#pragma unroll
                for (int i = 0; i < 8; ++i) ra[i] = *(const v4u*)(ag + (size_t)i * 16 * K + kk + 256);
#pragma unroll
                for (int i = 0; i < 4; ++i) rb[i] = *(const v4u*)(bg + (size_t)i * 16 * K + kk + 256);
            }
#pragma unroll
            for (int j = 0; j < 8; ++j) { const bf16x8 a = *(const bf16x8*)(As + (wave * 16 + fr) * 264 + 32 * j + 8 * fq);
#pragma unroll
                for (int nt = 0; nt < 4; ++nt) { const bf16x8 b = *(const bf16x8*)(Bs + (16 * nt + fr) * 264 + 32 * j + 8 * fq); acc[nt] = MFMA16(b, a, acc[nt]); } }
        }
        const int row = m0 + fr;
#pragma unroll
        for (int nt = 0; nt < 4; ++nt) { const int col = n0 + 16 * nt + 4 * fq; f32x4 v = acc[nt];
            if (MODE == 0) { if (col < scale_cols) v = v * scale0; v2u w; w.x = pk2(v[0], v[1]); w.y = pk2(v[2], v[3]); *(v2u*)(Ob + (size_t)(row_base + row) * ldo + col) = w; }
            else if (MODE == 1) {
#pragma unroll
                for (int e = 0; e < 4; ++e) { const float a = fmaxf(v[e], 0.f); v[e] = a * a; }
                v2u w; w.x = pk2(v[0], v[1]); w.y = pk2(v[2], v[3]); *(v2u*)(Ob + (size_t)(row_base + row) * ldo + col) = w; }
            else if (MODE == 2) {
                if (col < 3072) { v2u w; w.x = pk2(v[0], v[1]); w.y = pk2(v[2], v[3]); *(v2u*)(Ob + (size_t)(row_base + row) * 3072 + col) = w; }
                else if (col < 3104) { *(f32x4*)(Of + (size_t)(row_base + row) * 32 + (col - 3072)) = v + *(const f32x4*)(vec + (col - 3072)); } }
            else if (MODE == 4) { if (col < 32) *(f32x4*)(Of + (size_t)(row_base + row) * 32 + col) = v + *(const f32x4*)(vec + col); }
            else { const f32x4 g = *(const f32x4*)(vec + col); *(f32x4*)(Of + ((size_t)ks * 512 + row) * 1024 + col) = g * v; }
        }
    }
}

#define XB_TMO      128
#define XB_XCNT(j)  (256  + 64 * (j))
#define XB_XSUB(j)  (1280 + 64 * (j))
#define XB_XGEN(j)  (2304 + 64 * (j))
#define XB_TOP      3328
#define XB_TOPGEN   3392
#define XCD_BAR_WORDS 3456
#define XB_SPIN_CAP (1u << 18)

__device__ __forceinline__ unsigned xb_ld(unsigned* p)              { return __hip_atomic_load(p, __ATOMIC_RELAXED, __HIP_MEMORY_SCOPE_AGENT); }
__device__ __forceinline__ unsigned xb_add(unsigned* p, unsigned v) { return __hip_atomic_fetch_add(p, v, __ATOMIC_RELAXED, __HIP_MEMORY_SCOPE_AGENT); }
__device__ __forceinline__ unsigned xb_xcc_id() { return (unsigned)__builtin_amdgcn_s_getreg((3 << 11) | 20) & 0xFu; }
#define XB_SPIN(cond, bar) do { unsigned _sp = 0; while (cond) { __builtin_amdgcn_s_sleep(1); \
    if ((++_sp & 255u) == 0u) { if (xb_ld(&(bar)[XB_TMO])) break; if (_sp > XB_SPIN_CAP) { atomicAdd(&(bar)[XB_TMO], 1u); break; } } } } while (0)

struct XcdBarrier {
    unsigned* bar; unsigned x;
    volatile LAS unsigned* st;
};

__device__ __forceinline__ XcdBarrier xcd_barrier_post(unsigned* bar, volatile LAS unsigned* st) {
    XcdBarrier b; b.bar = bar; b.x = xb_xcc_id(); b.st = st;
    if (threadIdx.x == 0) (void)xb_add(&bar[XB_XCNT(b.x)], 1u);
    return b;
}
__device__ __forceinline__ void xcd_barrier_complete(unsigned* bar, unsigned x, unsigned& nloc, unsigned& nx) {
    const unsigned G = gridDim.x * gridDim.y * gridDim.z;
    unsigned sum, cnt, mine, sp = 0u;
    for (;;) {
        sum = 0u; cnt = 0u; mine = 0u;
#pragma unroll
        for (unsigned j = 0; j < 16; ++j) { const unsigned c = xb_ld(&bar[XB_XCNT(j)]); sum += c; cnt += (c > 0u) ? 1u : 0u; mine = (j == x) ? c : mine; }
        if (sum == G) break;
        __builtin_amdgcn_s_sleep(1);
        if ((++sp & 255u) == 0u) { if (xb_ld(&bar[XB_TMO])) break; if (sp > XB_SPIN_CAP) { atomicAdd(&bar[XB_TMO], 1u); break; } }
    }
    nloc = mine > 0u ? mine : 1u; nx = cnt > 0u ? cnt : 1u;
}

__device__ __forceinline__ void xcd_barrier(const XcdBarrier& b) {
    asm volatile("s_waitcnt vmcnt(0)" ::: "memory");
    __syncthreads();
    if (threadIdx.x == 0) {
        unsigned* bar = b.bar;
        __builtin_amdgcn_s_waitcnt(0);
        unsigned nloc = b.st[0], nx = b.st[1];
        if (nloc == 0u) { xcd_barrier_complete(bar, b.x, nloc, nx); b.st[0] = nloc; b.st[1] = nx; }
        const unsigned old = xb_add(&bar[XB_XSUB(b.x)], 1u);
        const unsigned gen = old / nloc;
        if (old + 1u == (gen + 1u) * nloc) {
            __builtin_amdgcn_fence(__ATOMIC_RELEASE, "agent");
            asm volatile("s_waitcnt vmcnt(0)" ::: "memory");
            const unsigned og = xb_add(&bar[XB_TOP], 1u);
            const unsigned tg = og / nx;
            if (og + 1u == (tg + 1u) * nx) xb_add(&bar[XB_TOPGEN], 1u);
            else XB_SPIN(xb_ld(&bar[XB_TOPGEN]) == tg, bar);
            __builtin_amdgcn_fence(__ATOMIC_ACQUIRE, "agent");
            xb_add(&bar[XB_XGEN(b.x)], 1u);
            asm volatile("s_waitcnt vmcnt(0)" ::: "memory");
        } else {
            XB_SPIN(xb_ld(&bar[XB_XGEN(b.x)]) == gen, bar);
            __builtin_amdgcn_fence(__ATOMIC_ACQUIRE, "agent");
            asm volatile("s_waitcnt vmcnt(0)" ::: "memory");
        }
    }
    __syncthreads();
}

#ifndef XP_MIX
#define XP_MIX 0
#endif
#ifndef XP_CTX
#define XP_CTX 0
#endif
#ifndef XP_P5
#define XP_P5 0
#endif
#ifndef XP_NORM
#define XP_NORM 0
#endif
#ifndef XP_PRO
#define XP_PRO 0
#endif
#ifndef XP_GST
#define XP_GST 0
#endif
__global__ void __launch_bounds__(NTHR, 2) fwd_megakernel(Params pk) {
    extern __shared__ __attribute__((aligned(16))) unsigned char lds[];
    if (threadIdx.x == 0) *(Params*)(lds + PARAM_OFF) = pk;
    if (threadIdx.x < 16) ((unsigned*)(lds + 131072))[threadIdx.x] = 0u;
    __syncthreads();
    (void)xcd_barrier_post((unsigned*)(pk.ws + WS_BAR), (volatile LAS unsigned*)((LAS unsigned char*)lds + 131072));
#pragma unroll 1
    for (int ph = 0; ph < 37; ++ph) {
        if (ph > 0) { const int l_ = (ph - 1) / 9, st_ = (ph - 1) % 9;
            if (((st_ == 3 || st_ == 4) && (l_ % 3) != 0) || st_ == 6 || (st_ == 0 && l_ > 0)) continue; }
        asm volatile("" ::: "memory");
        Params p;
        { const unsigned* src = (const unsigned*)(lds + PARAM_OFF); unsigned* dstw = (unsigned*)&p;
#pragma unroll
          for (int i = 0; i < (int)(sizeof(Params) / 4); ++i) dstw[i] = (unsigned)__builtin_amdgcn_readfirstlane((int)src[i]); }
#define GP(f) do { __attribute__((address_space(1))) char* g_ = (__attribute__((address_space(1))) char*)(char*)(p.f); asm volatile("" : "+s"(g_)); p.f = (decltype(p.f))(char*)g_; } while (0)
        GP(x); GP(c); GP(ctx); GP(c_ctx); GP(ada_w); GP(ada_b); GP(norm_g); GP(final_g); GP(mlp_w1); GP(mlp_w2); GP(a_w_in); GP(a_w_gate); GP(a_b_gate); GP(a_head_g); GP(a_w_out);
        GP(b_w_qkv); GP(b_sinks); GP(b_w_out); GP(c_w_in); GP(c_conv_w); GP(c_conv_b); GP(c_w_out); GP(out); GP(ws);
#undef GP
        unsigned char* ws = p.ws;
        const int G = gridDim.x, bx = blockIdx.x;
        LAS unsigned char* ldsl = (LAS unsigned char*)lds;
        if (ph == 0) { phase_prologue(p, lds); }
        else {
            const int l = (ph - 1) / 9, step = (ph - 1) % 9, kind = l % 3, jx = l / 3;
            const bool ctx_out = l != 3;
            const float* ml = (const float*)(ws + WS_MOD) + (size_t)l * 3 * 6144;
            bf16* XN = (bf16*)(ws + WS_XN); bf16* HG = (bf16*)(ws + WS_HG); bf16* ACT = (bf16*)(ws + WS_ACT);
            unsigned* cctr = (unsigned*)(ws + WS_XCNT) + 8 * 64 * 64;
            if (step == 0) { phase_norm(p, MT, p.norm_g, ml + 0 * 1024, ml + 1 * 1024, 0); }
            else if (step == 1) {
                const bf16* XNC = XN + (size_t)ML * D;
                unsigned* wc_ = l > 0 ? cctr + 64 * (2 * l) : nullptr;
                if (l > 0) ctx_norm_part(p, p.norm_g + (size_t)(l * 2 + 0) * D, ml + 0 * 1024, ml + 1 * 1024, 4, wc_);
                if (kind == 0) { const bf16* W = (const bf16*)(ws + WS_AIN) + (size_t)jx * 3328 * D;
                    { pg8::Gemm g{XN, W, ML, 3072, D}; pg8::StaticOrder S; S.init(ML, 3072, G, bx);
                      pg8::EpiStore<0> E{ACT, 3072};
                      pg8::gemm_phase<pg8::EpiStore<0>, pg8::StaticOrder, true, true>(ldsl, g, S, E); }
                    ctx_gemm<0>(lds, XNC, W, 3072, D, 1, ACT, 3072, nullptr, nullptr, 1.f, 0, wc_);
                    ctx_gemm<4>(lds, XN, W + (size_t)3072 * D, 32, D, 1, nullptr, 0, (float*)(ws + WS_G), p.a_b_gate + jx * 32, 1.f, 0, wc_, 0, MT / 128, true); }
                else if (kind == 1) { const bf16* W = (const bf16*)(ws + WS_BQKV);
                    { pg8::Gemm g{XN, W, ML, 1536, D}; pg8::StaticOrder S; S.init(ML, 1536, G, bx);
                      pg8::EpiQkvRope E{ACT, (const float*)(ws + WS_ROPE), (const float*)(ws + WS_ROPE) + 2048};
                      pg8::gemm_phase<pg8::EpiQkvRope, pg8::StaticOrder, true, true>(ldsl, g, S, E); }
                    ctx_gemm<0>(lds, XNC, W, 1536, D, 1, ACT, 1536, nullptr, nullptr, 0.18033688011112042f, 1024, wc_); }
                else { const bf16* W = (const bf16*)(ws + WS_CIN);
                    { pg8::Gemm g{XN, W, ML, 3072, D}; pg8::StaticOrder S; S.init(ML, 3072, G, bx);
                      pg8::EpiStore<0> E{ACT, 3072};
                      pg8::gemm_phase<pg8::EpiStore<0>, pg8::StaticOrder, true, true>(ldsl, g, S, E); }
                    ctx_gemm<0>(lds, XNC, W, 3072, D, 1, ACT, 3072, nullptr, nullptr, 1.f, 0, wc_); }
            }
            else if (step == 2) {
                if (kind == 0) phase_mlstm_local(p, lds); else if (kind == 1) phase_attn(p, lds, ctx_out); else phase_conv(p, MT); }
            else if (step == 3) { phase_mlstm_scan(p); }
            else if (step == 4) { phase_mlstm_out(p, lds, jx, ctx_out); }
            else if (step == 5 || step == 8) {
                const bool dn = step == 8;
                const bf16* wout = kind == 0 ? (const bf16*)(ws + WS_AOUT) + (size_t)jx * D * D : (kind == 1 ? (const bf16*)(ws + WS_BOUT) : (const bf16*)(ws + WS_COUT));
                const bf16* Aop = dn ? ACT : HG; const bf16* W = dn ? (const bf16*)(ws + WS_W2) + (size_t)l * D * FF : wout; const int Kd = dn ? FF : D;
                const int fin = (dn && l == 3) ? 1 : 0, fi = 2 * l + (dn ? 1 : 0);
                const float* mn = dn ? ml + 3 * 6144 : ml;
                const float* ng = fin ? p.final_g : p.norm_g + (size_t)(dn ? (l + 1) * 2 : l * 2 + 1) * D;
                const float* nsh = fin ? ml : mn + (dn ? 0 : 3) * 1024; const float* nsc = fin ? ml : mn + (dn ? 1 : 4) * 1024;
                { pg8::Gemm g{Aop, W, ML, D, Kd}; pg8::StaticOrder S; S.init(ML, D, G, bx);
                  pg8::EpiResidNorm E{p.out, XN, ml + (dn ? 5 : 2) * 1024, ng, nsh, nsc, (unsigned*)(ws + WS_XSLOT) + (size_t)fi * ML * 4, (unsigned*)(ws + WS_XCNT) + fi * 64 * 64, fin};
                  pg8::gemm_phase<pg8::EpiResidNorm, pg8::StaticOrder, false, true>(ldsl, g, S, E); }
                if (ctx_out) ctx_gemm<3>(lds, Aop + (size_t)ML * Kd, W, D, Kd, 4, nullptr, 0, (float*)(ws + WS_PART), ml + 2 * 6144 + (dn ? 5 : 2) * 1024, 1.f, 0, nullptr);
            }
            else { const bf16* W = (const bf16*)(ws + WS_W1) + (size_t)l * D * FF;
                unsigned* wc_ = cctr + 64 * (2 * l + 1);
                if (ctx_out) ctx_norm_part(p, p.norm_g + (size_t)(l * 2 + 1) * D, ml + 3 * 1024, ml + 4 * 1024, 4, wc_);
                { pg8::Gemm g{XN, W, ML, FF, D}; pg8::StaticOrder S; S.init(ML, FF, G, bx);
                  pg8::EpiStore<1> E{ACT, FF};
                  pg8::gemm_phase<pg8::EpiStore<1>, pg8::StaticOrder, true, true>(ldsl, g, S, E); }
                if (ctx_out) ctx_gemm<1>(lds, XN + (size_t)ML * D, W, FF, D, 1, ACT, FF, nullptr, nullptr, 1.f, 0, wc_); }
        }
        if (ph == 36) break;
        { XcdBarrier xb; xb.bar = (unsigned*)(ws + WS_BAR); xb.x = xb_xcc_id(); xb.st = (volatile LAS unsigned*)(ldsl + 131072); xcd_barrier(xb); }
    }
}

extern "C" void kernel_launch(void* const* d_in, const int* in_sizes, int n_in, void* d_out, int out_size, void* d_ws, size_t ws_size, hipStream_t stream) {
    static int grid = 0;
    if (grid == 0) {
        if (n_in != 22 || ws_size < WS_END) { fprintf(stderr, "kernel_launch: unexpected n_in %d / ws_size %zu (need %zu)\n", n_in, ws_size, (size_t)WS_END); grid = -1; return; }
        int dev = 0, cus = 0, per_cu = 0;
        hipGetDevice(&dev); hipDeviceGetAttribute(&cus, hipDeviceAttributeMultiprocessorCount, dev);
        if (hipFuncSetAttribute((const void*)fwd_megakernel, hipFuncAttributeMaxDynamicSharedMemorySize, LDS_BYTES) != hipSuccess) { fprintf(stderr, "kernel_launch: hipFuncSetAttribute failed\n"); grid = -1; return; }
        if (hipOccupancyMaxActiveBlocksPerMultiprocessor(&per_cu, (const void*)fwd_megakernel, NTHR, LDS_BYTES) != hipSuccess || per_cu < 1) { fprintf(stderr, "kernel_launch: occupancy query reports %d\n", per_cu); per_cu = 1; }
        (void)hipGetLastError();
        if (cus != 256) { fprintf(stderr, "kernel_launch: built for a 256-CU device (one 256x256 unit per workgroup in the fused residual+norm GEMM phases); found %d\n", cus); grid = -1; return; }
        grid = cus * 1;
    }
    if (grid < 0) return;
    if (hipMemsetAsync((char*)d_ws + WS_XCNT, 0, ZERO_BYTES, stream) != hipSuccess) { fprintf(stderr, "kernel_launch: memset failed\n"); return; }
    Params p{};
    const float** pp = (const float**)&p;
    for (int i = 0; i < 22; ++i) pp[i] = (const float*)d_in[i];
    p.out = (float*)d_out; p.ws = (unsigned char*)d_ws;
    void* args[] = {&p};
    hipError_t e = hipLaunchCooperativeKernel((const void*)fwd_megakernel, dim3(grid), dim3(NTHR), args, LDS_BYTES, stream);
    if (e != hipSuccess) fprintf(stderr, "cooperative launch failed: %s (grid %d)\n", hipGetErrorString(e), grid);
}
```

```cpp
#include <hip/hip_runtime.h>
#include <hip/hip_cooperative_groups.h>
#include <cstdio>
#include <cstdint>
namespace cg = cooperative_groups;

namespace pg8 {
#define PG8_LAS __attribute__((address_space(3)))
typedef unsigned short bf16_t;
typedef short bf16x8 __attribute__((ext_vector_type(8)));
typedef float f32x4 __attribute__((ext_vector_type(4)));
typedef unsigned u32x4 __attribute__((ext_vector_type(4)));
constexpr int BM = 256, BK = 64, HALF = 128, HTB = HALF * BK * 2  , STAGE_BYTES = 8 * HTB, NXCD = 8, WGM = 8;

__host__ __device__ __forceinline__ int lds_byte(int r, int c) { const int st = (r >> 4) * 2 + (c >> 5), rr = r & 15, cc = c & 31, ob = rr * 64 + cc * 2; return st * 1024 + (ob ^ (((ob >> 9) & 1) << 5)); }
__host__ __device__ __forceinline__ void stage_rc(int b, int& R, int& C) { const int st = b / 1024, sb = b % 1024, swz = sb ^ (((sb >> 9) & 1) << 5); R = (st >> 1) * 16 + swz / 64; C = (st & 1) * 32 + (swz % 64) / 2; }
__host__ __device__ __forceinline__ int perm32(int rho) { const int n = rho >> 4, i = rho & 15; return 8 * (i >> 2) + 4 * n + (i & 3); }

struct Unit { int pm, pn; };
struct Gemm { const bf16_t* A; const bf16_t* Bt; int M, N, K; };

struct StaticOrder {
    int nM, nN, nwg, G, c;
    __host__ __device__ void init(int M, int N, int G_, int c_) { nM = M / BM; nN = N / BM; nwg = nM * nN; G = G_; c = c_; }
    __host__ __device__ bool next(int i, Unit& u) const {
        const long L = (long)i * G + c; if (L >= nwg) return false;
        int wgid = (int)L; { const int q = nwg / NXCD, r = nwg % NXCD, xcd = wgid % NXCD, off = wgid / NXCD; wgid = (xcd < r ? xcd * (q + 1) : r * (q + 1) + (xcd - r) * q) + off; }
        const int nig = WGM * nN, gid = wgid / nig, fm = gid * WGM, gsz = (nM - fm) < WGM ? (nM - fm) : WGM;
        u.pm = fm + ((wgid % nig) % gsz); u.pn = (wgid % nig) / gsz; return true;
    }
    __device__ __forceinline__ void a_ready(const Unit&) const {}
    __device__ __forceinline__ void done(const Unit&) const {}
};

__device__ __forceinline__ unsigned cvt_pk_bf16(float lo, float hi) { unsigned r; asm volatile("v_cvt_pk_bf16_f32 %0, %1, %2" : "=v"(r) : "v"(lo), "v"(hi)); return r; }
typedef float f32x2 __attribute__((ext_vector_type(2)));
typedef unsigned u32x2 __attribute__((ext_vector_type(2)));
constexpr int ROWS_LAT = 16384;

template <int ACT> struct EpiStore {
    static constexpr bool PERM = true, AFTER_DRAIN = false;
    bf16_t* O; int ldc;
    __device__ __forceinline__ void operator()(const f32x4 (&acc)[2][2][4][2], const Unit& u, int wr, int wc, int fr, int fq) const {
        const int row0 = u.pm * BM + wr * 64 + fr, col0 = u.pn * BM + wc * 32 + 8 * fq;
#pragma unroll
        for (int ai = 0; ai < 2; ++ai)
#pragma unroll
            for (int m = 0; m < 4; ++m) { bf16_t* rowp = O + (size_t)(row0 + ai * HALF + m * 16) * ldc + col0;
#pragma unroll
                for (int bj = 0; bj < 2; ++bj) { f32x4 v0 = acc[ai][bj][m][0], v1 = acc[ai][bj][m][1];
                    if (ACT == 1) {
#pragma unroll
                        for (int e = 0; e < 4; ++e) { float a = fmaxf(v0[e], 0.f), b = fmaxf(v1[e], 0.f); v0[e] = a * a; v1[e] = b * b; } }
                    u32x4 w; w.x = cvt_pk_bf16(v0[0], v0[1]); w.y = cvt_pk_bf16(v0[2], v0[3]); w.z = cvt_pk_bf16(v1[0], v1[1]); w.w = cvt_pk_bf16(v1[2], v1[3]);
                    *(u32x4*)(rowp + bj * HALF) = w; } }
    }
};
struct EpiAIn {
    static constexpr bool PERM = true, AFTER_DRAIN = false;
    bf16_t* O; float* G; const float* bg;
    __device__ __forceinline__ void operator()(const f32x4 (&acc)[2][2][4][2], const Unit& u, int wr, int wc, int fr, int fq) const {
        const int row0 = u.pm * BM + wr * 64 + fr;
        if (u.pn < 12) {
            const int col0 = u.pn * BM + wc * 32 + 8 * fq;
#pragma unroll
            for (int ai = 0; ai < 2; ++ai)
#pragma unroll
                for (int m = 0; m < 4; ++m) { bf16_t* rowp = O + (size_t)(row0 + ai * HALF + m * 16) * 3072 + col0;
#pragma unroll
                    for (int bj = 0; bj < 2; ++bj) { const f32x4 v0 = acc[ai][bj][m][0], v1 = acc[ai][bj][m][1];
                        u32x4 w; w.x = cvt_pk_bf16(v0[0], v0[1]); w.y = cvt_pk_bf16(v0[2], v0[3]); w.z = cvt_pk_bf16(v1[0], v1[1]); w.w = cvt_pk_bf16(v1[2], v1[3]);
                        *(u32x4*)(rowp + bj * HALF) = w; } }
        } else if (wc == 0) {
            const f32x4 b0 = *(const f32x4*)(bg + 8 * fq), b1 = *(const f32x4*)(bg + 8 * fq + 4);
#pragma unroll
            for (int ai = 0; ai < 2; ++ai)
#pragma unroll
                for (int m = 0; m < 4; ++m) { float* gp = G + (size_t)(row0 + ai * HALF + m * 16) * 32 + 8 * fq;
                    *(f32x4*)gp = acc[ai][0][m][0] + b0; *(f32x4*)(gp + 4) = acc[ai][0][m][1] + b1; }
        }
    }
};
struct EpiQkvRope {
    static constexpr bool PERM = false, AFTER_DRAIN = false;
    bf16_t* O; const float* ct; const float* st;
    __device__ __forceinline__ void operator()(const f32x4 (&acc)[2][2][4][2], const Unit& u, int wr, int wc, int fr, int fq) const {
        const int colb = u.pn * BM + wc * 32 + 4 * fq;
        const bool rope = (u.pm < 64) && (u.pn < 5);
        const float sc = (u.pn < 4) ? 0.18033688011112042f : 1.0f;
#pragma unroll
        for (int ai = 0; ai < 2; ++ai)
#pragma unroll
            for (int m = 0; m < 4; ++m) { const int row = u.pm * BM + ai * HALF + wr * 64 + m * 16 + fr;
                f32x4 c = (f32x4){1.f, 1.f, 1.f, 1.f}, s = (f32x4){0.f, 0.f, 0.f, 0.f};
                if (rope) { const int sq = row & 8191; const int pos = (wc & 1) ? (sq & 63) : (sq >> 6); c = *(const f32x4*)(ct + pos * 16 + 4 * fq); s = *(const f32x4*)(st + pos * 16 + 4 * fq); }
                bf16_t* rowp = O + (size_t)row * 1536 + colb;
#pragma unroll
                for (int bj = 0; bj < 2; ++bj) { const f32x4 x1 = acc[ai][bj][m][0], x2 = acc[ai][bj][m][1];
                    const f32x4 o1 = (x1 * c - x2 * s) * sc, o2 = (x2 * c + x1 * s) * sc;
                    u32x2 w1, w2; w1.x = cvt_pk_bf16(o1[0], o1[1]); w1.y = cvt_pk_bf16(o1[2], o1[3]); w2.x = cvt_pk_bf16(o2[0], o2[1]); w2.y = cvt_pk_bf16(o2[2], o2[3]);
                    *(u32x2*)(rowp + bj * HALF) = w1; *(u32x2*)(rowp + bj * HALF + 16) = w2; } }
    }
};
struct EpiResid {
    static constexpr bool PERM = false, AFTER_DRAIN = false;
    float* hl; float* hc; const float* gate;
    __device__ __forceinline__ void operator()(const f32x4 (&acc)[2][2][4][2], const Unit& u, int wr, int wc, int fr, int fq) const {
        const int r = (u.pm < 64) ? (u.pm >> 5) : 2;
        float* hb = (u.pm < 64) ? hl : (hc - (size_t)ROWS_LAT * 1024);
        const int col0 = u.pn * BM + wc * 32 + 4 * fq;
        const float* gp = gate + r * 6144 + col0;
        f32x4 gv[2][2];
#pragma unroll
        for (int bj = 0; bj < 2; ++bj)
#pragma unroll
            for (int n = 0; n < 2; ++n) gv[bj][n] = *(const f32x4*)(gp + bj * HALF + n * 16);
#pragma unroll
        for (int ai = 0; ai < 2; ++ai)
#pragma unroll
            for (int m = 0; m < 4; ++m) { float* p = hb + (size_t)(u.pm * BM + ai * HALF + wr * 64 + m * 16 + fr) * 1024 + col0;
#pragma unroll
                for (int bj = 0; bj < 2; ++bj)
#pragma unroll
                    for (int n = 0; n < 2; ++n) { f32x4 hv = *(const f32x4*)(p + bj * HALF + n * 16); hv = hv + gv[bj][n] * acc[ai][bj][m][n]; *(f32x4*)(p + bj * HALF + n * 16) = hv; }
                if (m & 1) asm volatile("" ::: "memory"); }
    }
};


__device__ __forceinline__ float shx_pg(float v, int o, int lane) { return __builtin_bit_cast(float, __builtin_amdgcn_ds_bpermute((lane ^ o) << 2, __builtin_bit_cast(int, v))); }
struct EpiResidNorm {
    static constexpr bool PERM = false, AFTER_DRAIN = true;
    float* h; const float* hsrc; bf16_t* xn; const float* gate; const float* g; const float* shift; const float* scale; unsigned* xslots; unsigned* cnt; int fin;
    __device__ __forceinline__ void operator()(const f32x4 (&)[2][2][4][2], const Unit&, int, int, int, int) const {}
    __device__ __forceinline__ void fused(f32x4 (&acc)[2][2][4][2], const Unit& u, int wr, int wc, int fr, int fq, PG8_LAS unsigned char* lds, int wid, int lane) const {
        const int r = u.pm >> 5, col0 = u.pn * BM + wc * 32 + 4 * fq;
        PG8_LAS float* Pl = (PG8_LAS float*)lds; PG8_LAS float* Sl = (PG8_LAS float*)(lds + 4096);
        {
            const float* gp = gate + r * 6144 + col0; f32x4 gv[2][2];
#pragma unroll
            for (int bj = 0; bj < 2; ++bj)
#pragma unroll
                for (int n = 0; n < 2; ++n) gv[bj][n] = *(const f32x4*)(gp + bj * HALF + n * 16);
#pragma unroll
            for (int ai = 0; ai < 2; ++ai)
#pragma unroll
                for (int m = 0; m < 4; ++m) { const float* p = hsrc + (size_t)(u.pm * BM + ai * HALF + wr * 64 + m * 16 + fr) * 1024 + col0;
#pragma unroll
                    for (int bj = 0; bj < 2; ++bj)
#pragma unroll
                        for (int n = 0; n < 2; ++n) { const f32x4 hv = *(const f32x4*)(p + bj * HALF + n * 16); acc[ai][bj][m][n] = hv + gv[bj][n] * acc[ai][bj][m][n]; }
                    asm volatile("" : "+v"(acc[ai][0][m][0]), "+v"(acc[ai][0][m][1]), "+v"(acc[ai][1][m][0]), "+v"(acc[ai][1][m][1]) :: "memory"); }
        }
#pragma unroll
        for (int ai = 0; ai < 2; ++ai)
#pragma unroll
            for (int m = 0; m < 4; ++m) { float s = 0.f;
#pragma unroll
                for (int bj = 0; bj < 2; ++bj)
#pragma unroll
                    for (int n = 0; n < 2; ++n) { const f32x4 x = acc[ai][bj][m][n]; s += (x[0] * x[0] + x[1] * x[1]) + (x[2] * x[2] + x[3] * x[3]); }
                s += shx_pg(s, 16, lane); s += shx_pg(s, 32, lane);
                if (fq == 0) Pl[(ai * HALF + wr * 64 + m * 16 + fr) * 4 + wc] = s; }
        asm volatile("s_waitcnt lgkmcnt(0)" ::: "memory"); __builtin_amdgcn_s_barrier(); asm volatile("" ::: "memory");
        const int tid = wid * 64 + lane;
        if (tid < 256) { const float tot = (Pl[tid * 4 + 0] + Pl[tid * 4 + 1]) + (Pl[tid * 4 + 2] + Pl[tid * 4 + 3]);
            __hip_atomic_store(xslots + ((size_t)(u.pm * BM + tid)) * 4 + u.pn, __builtin_bit_cast(unsigned, tot), __ATOMIC_RELAXED, __HIP_MEMORY_SCOPE_AGENT); }
        asm volatile("s_waitcnt vmcnt(0)" ::: "memory");
        if (wid < 4 && lane == 0) __hip_atomic_fetch_add(cnt + 64 * u.pm, 1u, __ATOMIC_RELAXED, __HIP_MEMORY_SCOPE_AGENT);
        if (wid == 0) { unsigned sp = 0;
            while ((unsigned)__builtin_amdgcn_readfirstlane((int)__hip_atomic_load(cnt + 64 * u.pm, __ATOMIC_RELAXED, __HIP_MEMORY_SCOPE_AGENT)) < 16u) { __builtin_amdgcn_s_sleep(2); if (++sp > (1u << 22)) break; }
            __builtin_amdgcn_fence(__ATOMIC_ACQUIRE, "agent"); }
        asm volatile("s_waitcnt vmcnt(0) lgkmcnt(0)" ::: "memory"); __builtin_amdgcn_s_barrier(); asm volatile("" ::: "memory");
        if (tid < 256) { const unsigned* sl = xslots + ((size_t)(u.pm * BM + tid)) * 4; float q = 0.f;
#pragma unroll
            for (int t = 0; t < 4; ++t) q += __builtin_bit_cast(float, __hip_atomic_load(sl + t, __ATOMIC_RELAXED, __HIP_MEMORY_SCOPE_AGENT));
            Sl[tid] = __builtin_amdgcn_rsqf(q * (1.0f / 1024.0f) + 1e-6f); }
        asm volatile("s_waitcnt lgkmcnt(0)" ::: "memory"); __builtin_amdgcn_s_barrier(); asm volatile("" ::: "memory");
        f32x4 gm[2][2], sh[2][2];
#pragma unroll
        for (int bj = 0; bj < 2; ++bj)
#pragma unroll
            for (int n = 0; n < 2; ++n) { const int c = col0 + bj * HALF + n * 16; const f32x4 gg = *(const f32x4*)(g + c);
                if (fin) { gm[bj][n] = gg; sh[bj][n] = (f32x4){0.f, 0.f, 0.f, 0.f}; }
                else { gm[bj][n] = gg * (*(const f32x4*)(scale + r * 6144 + c) + 1.0f); sh[bj][n] = *(const f32x4*)(shift + r * 6144 + c); } }
#pragma unroll
        for (int ai = 0; ai < 2; ++ai)
#pragma unroll
            for (int m = 0; m < 4; ++m) { const int rl = ai * HALF + wr * 64 + m * 16 + fr; const float rs = Sl[rl]; const size_t off = (size_t)(u.pm * BM + rl) * 1024 + col0;
#pragma unroll
                for (int bj = 0; bj < 2; ++bj)
#pragma unroll
                    for (int n = 0; n < 2; ++n) { const f32x4 x = acc[ai][bj][m][n];
                        if (fin) { *(f32x4*)(h + off + bj * HALF + n * 16) = (x * rs) * gm[bj][n]; }
                        else { *(f32x4*)(h + off + bj * HALF + n * 16) = x; const f32x4 y = (x * rs) * gm[bj][n] + sh[bj][n];
                            u32x2 w; w.x = cvt_pk_bf16(y[0], y[1]); w.y = cvt_pk_bf16(y[2], y[3]); *(u32x2*)(xn + off + bj * HALF + n * 16) = w; } }
                asm volatile("" ::: "memory"); }
    }
};

template <class Epi, class Sched, bool ALIGN_EPI = false, bool SP2 = false>
__device__ __forceinline__ void gemm_phase(PG8_LAS unsigned char* lds, const Gemm g, const Sched& S, const Epi& E) {
    int tid_ = threadIdx.x; asm volatile("" : "+v"(tid_)); const int tid = tid_, wid = __builtin_amdgcn_readfirstlane(tid >> 6), lane = tid & 63, wr = wid >> 2, wc = wid & 3, fr = lane & 15, fq = lane >> 4;
    const int K = g.K, nt = K / BK;
    unsigned voffA[2], voffB[2];
#pragma unroll
    for (int i = 0; i < 2; ++i) { int R, C; stage_rc(tid * 16 + i * 8192, R, C); const int Rb = Epi::PERM ? ((R & ~31) + perm32(R & 31)) : R;
        voffA[i] = (unsigned)(R * K + C) * 2u; voffB[i] = (unsigned)(Rb * K + C) * 2u; }
    const size_t kstep = (size_t)(BK * 2);
    const size_t hstep = (size_t)HALF * K * 2;
    const size_t tstep = 2 * hstep;
    const unsigned ldsw = (unsigned)wid * 1024u;
    const int aoff = lds_byte(wr * 64 + fr, fq * 8), boff = lds_byte(wc * 32 + fr, fq * 8);
#define PG8_SA(b, h) (((b) * 2 + (h)) * HTB)
#define PG8_SB(b, h) ((4 + (b) * 2 + (h)) * HTB)
#define PG8_STAGE(bufoff, gbase, voff) do { _Pragma("unroll") for (int _i = 0; _i < 2; ++_i) \
        __builtin_amdgcn_global_load_lds((const unsigned*)((const char*)(gbase) + (voff)[_i]), (PG8_LAS unsigned*)(lds + (bufoff) + ldsw + _i * 8192), 16, 0, 0); } while (0)
#define PG8_LDA(dst, b, h) do { _Pragma("unroll") for (int m = 0; m < 4; ++m) _Pragma("unroll") for (int k = 0; k < 2; ++k) dst[m][k] = *(const PG8_LAS bf16x8*)(lds + PG8_SA(b, h) + aoff + m * 2048 + k * 1024); } while (0)
#define PG8_LDB(dst, b, h) do { _Pragma("unroll") for (int n = 0; n < 2; ++n) _Pragma("unroll") for (int k = 0; k < 2; ++k) dst[n][k] = *(const PG8_LAS bf16x8*)(lds + PG8_SB(b, h) + boff + n * 2048 + k * 1024); } while (0)
#define PG8_MMA(ai, bj, At, Bt) do { __builtin_amdgcn_s_setprio(1); _Pragma("unroll") for (int m = 0; m < 4; ++m) _Pragma("unroll") for (int n = 0; n < 2; ++n) _Pragma("unroll") for (int k = 0; k < 2; ++k) \
        acc[ai][bj][m][n] = __builtin_amdgcn_mfma_f32_16x16x32_bf16(Bt[n][k], At[m][k], acc[ai][bj][m][n], 0, 0, 0); __builtin_amdgcn_s_setprio(0); } while (0)
#define PG8_WAIT_V(n) asm volatile("s_waitcnt vmcnt(" #n ")" ::: "memory")
#define PG8_WAIT_L(n) asm volatile("s_waitcnt lgkmcnt(" #n ")" ::: "memory")
#define PG8_BAR __builtin_amdgcn_s_barrier()
#define PG8_SCHED __builtin_amdgcn_sched_barrier(0)
    Unit cur, nxt; int ui = 0;
    if (!S.next(0, cur)) return;
    f32x4 acc[2][2][4][2];
#pragma unroll
    for (int a = 0; a < 2; ++a)
#pragma unroll
        for (int b = 0; b < 2; ++b)
#pragma unroll
            for (int m = 0; m < 4; ++m)
#pragma unroll
                for (int n = 0; n < 2; ++n) acc[a][b][m][n] = (f32x4){0.f, 0.f, 0.f, 0.f};
    bf16x8 At[4][2], B0[2][2], B1[2][2];
    const char* cA = (const char*)g.A + (size_t)cur.pm * tstep; const char* cB = (const char*)g.Bt + (size_t)cur.pn * tstep;
    S.a_ready(cur);
    if constexpr (SP2) {
        PG8_STAGE(PG8_SB(0, 0), cB, voffB); PG8_STAGE(PG8_SB(0, 1), cB + hstep, voffB); PG8_STAGE(PG8_SA(0, 0), cA, voffA); PG8_STAGE(PG8_SA(0, 1), cA + hstep, voffA);
        if (wr == 1) PG8_BAR;
        PG8_WAIT_V(2); PG8_BAR;
        PG8_STAGE(PG8_SB(1, 0), cB + kstep, voffB); PG8_STAGE(PG8_SA(1, 0), cA + kstep, voffA); PG8_STAGE(PG8_SB(1, 1), cB + hstep + kstep, voffB);
        PG8_WAIT_V(6); PG8_BAR;
    } else {
        PG8_STAGE(PG8_SB(0, 0), cB, voffB); PG8_STAGE(PG8_SA(0, 0), cA, voffA); PG8_STAGE(PG8_SB(0, 1), cB + hstep, voffB); PG8_STAGE(PG8_SA(0, 1), cA + hstep, voffA);
        if (wr == 1) PG8_BAR;
        PG8_WAIT_V(4); PG8_BAR;
        PG8_STAGE(PG8_SB(1, 0), cB + kstep, voffB); PG8_STAGE(PG8_SA(1, 0), cA + kstep, voffA); PG8_STAGE(PG8_SB(1, 1), cB + hstep + kstep, voffB);
        PG8_WAIT_V(6); PG8_BAR;
    }
    for (;;) {
        const bool has_next = S.next(ui + 1, nxt);
        const char* nA = has_next ? (const char*)g.A + (size_t)nxt.pm * tstep : cA; const char* nB = has_next ? (const char*)g.Bt + (size_t)nxt.pn * tstep : cB;
        for (int t = 0; t < nt; t += 2) {
            const bool last = (t == nt - 2);
            const char* a1 = cA + (size_t)(t + 1) * kstep;
            const char* a2 = last ? nA : cA + (size_t)(t + 2) * kstep; const char* b2 = last ? nB : cB + (size_t)(t + 2) * kstep;
            const char* a3 = a2 + kstep; const char* b3 = b2 + kstep;
            if (last && has_next) S.a_ready(nxt);
            if constexpr (SP2) {
            PG8_LDB(B0, 0, 0); PG8_LDB(B1, 0, 1); PG8_SCHED; PG8_LDA(At, 0, 0); PG8_STAGE(PG8_SA(1, 1), a1 + hstep, voffA);
            PG8_WAIT_V(8); PG8_WAIT_L(0); PG8_BAR; PG8_MMA(0, 0, At, B0); PG8_MMA(0, 1, At, B1); PG8_BAR; PG8_SCHED;
            PG8_LDA(At, 0, 1); PG8_STAGE(PG8_SB(0, 0), b2, voffB); PG8_STAGE(PG8_SB(0, 1), b2 + hstep, voffB); PG8_STAGE(PG8_SA(0, 0), a2, voffA);
            PG8_WAIT_V(8); PG8_WAIT_L(0); PG8_BAR; PG8_MMA(1, 0, At, B0); PG8_MMA(1, 1, At, B1); PG8_BAR; PG8_SCHED;
            PG8_LDB(B0, 1, 0); PG8_LDB(B1, 1, 1); PG8_SCHED; PG8_LDA(At, 1, 0); PG8_STAGE(PG8_SA(0, 1), a2 + hstep, voffA);
            PG8_WAIT_V(8); PG8_WAIT_L(0); PG8_BAR; PG8_MMA(0, 0, At, B0); PG8_MMA(0, 1, At, B1); PG8_BAR; PG8_SCHED;
            PG8_LDA(At, 1, 1); PG8_STAGE(PG8_SB(1, 0), b3, voffB); PG8_STAGE(PG8_SB(1, 1), b3 + hstep, voffB); PG8_STAGE(PG8_SA(1, 0), a3, voffA);
            PG8_WAIT_V(8); PG8_WAIT_L(0); PG8_BAR; PG8_MMA(1, 0, At, B0); PG8_MMA(1, 1, At, B1); PG8_BAR; PG8_SCHED;
            } else {
            PG8_LDB(B0, 0, 0); PG8_SCHED; PG8_LDA(At, 0, 0); PG8_STAGE(PG8_SA(1, 1), a1 + hstep, voffA);
            PG8_WAIT_L(8); PG8_BAR; PG8_WAIT_L(0); PG8_MMA(0, 0, At, B0); PG8_BAR; PG8_SCHED;
            PG8_LDB(B1, 0, 1); PG8_STAGE(PG8_SB(0, 0), b2, voffB);
            PG8_BAR; PG8_WAIT_L(0); PG8_MMA(0, 1, At, B1); PG8_BAR;
            PG8_LDA(At, 0, 1); PG8_STAGE(PG8_SA(0, 0), a2, voffA);
            PG8_BAR; PG8_WAIT_L(0); PG8_MMA(1, 0, At, B0); PG8_BAR; PG8_SCHED;
            PG8_STAGE(PG8_SB(0, 1), b2 + hstep, voffB);
            PG8_WAIT_V(6); PG8_BAR; PG8_MMA(1, 1, At, B1); PG8_BAR;
            PG8_LDB(B0, 1, 0); PG8_SCHED; PG8_LDA(At, 1, 0); PG8_STAGE(PG8_SA(0, 1), a2 + hstep, voffA);
            PG8_WAIT_L(8); PG8_BAR; PG8_WAIT_L(0); PG8_MMA(0, 0, At, B0); PG8_BAR; PG8_SCHED;
            PG8_LDB(B1, 1, 1); PG8_STAGE(PG8_SB(1, 0), b3, voffB);
            PG8_BAR; PG8_WAIT_L(0); PG8_MMA(0, 1, At, B1); PG8_BAR;
            PG8_LDA(At, 1, 1); PG8_STAGE(PG8_SA(1, 0), a3, voffA);
            PG8_BAR; PG8_WAIT_L(0); PG8_MMA(1, 0, At, B0); PG8_BAR; PG8_SCHED;
            PG8_STAGE(PG8_SB(1, 1), b3 + hstep, voffB);
            PG8_WAIT_V(6); PG8_BAR; PG8_MMA(1, 1, At, B1); PG8_BAR;
            }
        }
        if constexpr (ALIGN_EPI) { if (wr == 0) PG8_BAR; }
        if constexpr (!Epi::AFTER_DRAIN) { E(acc, cur, wr, wc, fr, fq); S.done(cur); }
        if (!has_next) break;
#pragma unroll
        for (int a = 0; a < 2; ++a)
#pragma unroll
            for (int b = 0; b < 2; ++b)
#pragma unroll
                for (int m = 0; m < 4; ++m)
#pragma unroll
                    for (int n = 0; n < 2; ++n) acc[a][b][m][n] = (f32x4){0.f, 0.f, 0.f, 0.f};
        cur = nxt; cA = nA; cB = nB; ++ui;
        if constexpr (ALIGN_EPI) { if (wr == 1) PG8_BAR; }
    }
    PG8_WAIT_V(0);
    if constexpr (!ALIGN_EPI) { if (wr == 0) PG8_BAR; }
    PG8_BAR;
    if constexpr (Epi::AFTER_DRAIN) { E.fused(acc, cur, wr, wc, fr, fq, lds, wid, lane); S.done(cur); }
#undef PG8_SA
#undef PG8_SB
#undef PG8_STAGE
#undef PG8_LDA
#undef PG8_LDB
#undef PG8_MMA
#undef PG8_WAIT_V
#undef PG8_WAIT_L
#undef PG8_BAR
#undef PG8_SCHED
}
}

#define LAS __attribute__((address_space(3)))
typedef unsigned short bf16;
typedef float f32x4 __attribute__((ext_vector_type(4)));
typedef short bf16x8 __attribute__((ext_vector_type(8)));
typedef unsigned v4u __attribute__((ext_vector_type(4)));
typedef unsigned v2u __attribute__((ext_vector_type(2)));
constexpr int NWAVES = 8, NTHR = 512;
constexpr int D = 1024, SEQ = 8192, NBATCH = 2, CTXL = 256, FF = 4096;
constexpr int ML = NBATCH * SEQ, MT = ML + NBATCH * CTXL;
constexpr int NCH = 66;
constexpr int LDS_BYTES = 147456, PARAM_OFF = 131072 + 1024;
constexpr float NEG_BIG = -1.0e30f;

constexpr size_t MiB = 1u << 20;
constexpr size_t WS_MOD = 0;
constexpr size_t WS_ROPE = 512 * 1024;
constexpr size_t WS_MISC = 768 * 1024;
constexpr size_t WS_W1 = 1 * MiB;
constexpr size_t WS_W2 = WS_W1 + 32 * MiB;
constexpr size_t WS_AIN = WS_W2 + 32 * MiB;
constexpr size_t WS_AOUT = WS_AIN + 13 * MiB;
constexpr size_t WS_BQKV = WS_AOUT + 4 * MiB;
constexpr size_t WS_BOUT = WS_BQKV + 3 * MiB;
constexpr size_t WS_CIN = WS_BOUT + 2 * MiB;
constexpr size_t WS_COUT = WS_CIN + 6 * MiB;
constexpr size_t WS_HC = WS_COUT + 2 * MiB;
constexpr size_t WS_XN = WS_HC + 2 * MiB;
constexpr size_t WS_HG = WS_XN + 33 * MiB;
constexpr size_t WS_G = WS_HG + 33 * MiB;
constexpr size_t WS_DN = WS_G + 3 * MiB;
constexpr size_t WS_ACT = WS_DN + 1 * MiB;
constexpr size_t WS_DC = WS_XN;
constexpr size_t WS_CP = WS_ACT + 132 * MiB;
constexpr size_t WS_PART = WS_CP + 33 * MiB;
constexpr size_t WS_XCNT = WS_PART + 8 * MiB;
constexpr size_t XCNT_BYTES = 8 * 64 * 256 + 16 * 256;
constexpr size_t WS_BAR = WS_XCNT + 192 * 1024;
constexpr size_t ZERO_BYTES = 192 * 1024 + 16384;
constexpr size_t WS_XSLOT = WS_XCNT + 256 * 1024;
constexpr size_t WS_END = WS_XSLOT + 2 * MiB;

struct Params {
    const float *x, *c, *ctx, *c_ctx, *ada_w, *ada_b, *norm_g, *final_g, *mlp_w1, *mlp_w2;
    const float *a_w_in, *a_w_gate, *a_b_gate, *a_head_g, *a_w_out, *b_w_qkv, *b_sinks, *b_w_out, *c_w_in, *c_conv_w, *c_conv_b, *c_w_out;
    float* out; unsigned char* ws;
};

__device__ __forceinline__ unsigned f2bf(float f) { unsigned u = __builtin_bit_cast(unsigned, f); return (u + 0x7fffu + ((u >> 16) & 1u)) >> 16; }
typedef float f32x2_t __attribute__((ext_vector_type(2)));
typedef __bf16 bf16x2_t __attribute__((ext_vector_type(2)));
__device__ __forceinline__ unsigned pk2(float lo, float hi) { const f32x2_t v = {lo, hi}; const bf16x2_t b = __builtin_convertvector(v, bf16x2_t); return __builtin_bit_cast(unsigned, b); }
__device__ __forceinline__ float bf2f(unsigned short u) { return __builtin_bit_cast(float, (unsigned)u << 16); }
__device__ __forceinline__ float bflo(unsigned w) { return __builtin_bit_cast(float, w << 16); }
__device__ __forceinline__ float bfhi(unsigned w) { return __builtin_bit_cast(float, w & 0xffff0000u); }
__device__ __forceinline__ float shx(float v, int o, int lane) { return __builtin_bit_cast(float, __builtin_amdgcn_ds_bpermute((lane ^ o) << 2, __builtin_bit_cast(int, v))); }
__device__ __forceinline__ float shup(float v, int o, int lane) { const int src = lane >= o ? lane - o : lane; return __builtin_bit_cast(float, __builtin_amdgcn_ds_bpermute(src << 2, __builtin_bit_cast(int, v))); }
__device__ __forceinline__ float wave_sum(float v, int lane) {
#pragma unroll
    for (int o = 1; o < 64; o <<= 1) v += shx(v, o, lane);
    return v;
}
__device__ __forceinline__ float wave_max(float v, int lane) {
#pragma unroll
    for (int o = 1; o < 64; o <<= 1) v = fmaxf(v, shx(v, o, lane));
    return v;
}
__device__ __forceinline__ float logsig(float x) { return fminf(x, 0.f) - __logf(1.f + __expf(-fabsf(x))); }
__device__ __forceinline__ int chunk_row(int b, int j) { return j < 2 ? ML + b * 256 + j * 128 : b * SEQ + (j - 2) * 128; }
#define FRESH_IDS() int tid = threadIdx.x; asm volatile("" : "+v"(tid)); const int lane = tid & 63, wave = __builtin_amdgcn_readfirstlane(tid >> 6); (void)lane; (void)wave
#define MFMA16(a, b, c) __builtin_amdgcn_mfma_f32_16x16x32_bf16((a), (b), (c), 0, 0, 0)

__device__ __forceinline__ void p0_transpose_item(const float* W, int K, int N, bf16* WT, int row_off, LAS float* scr, int item, int lane) {
    const int nblk = N / 32, kb = item / nblk, nb = item % nblk, k0 = 64 * kb, n0 = 32 * nb;
#pragma unroll 8
    for (int i = 0; i < 32; ++i) { const int kk = 2 * i + (lane >> 5); scr[kk * 33 + (lane & 31)] = W[(size_t)(k0 + kk) * N + n0 + (lane & 31)]; }
    asm volatile("s_waitcnt lgkmcnt(0)" ::: "memory");
    const int c = lane & 7;
#pragma unroll
    for (int j = 0; j < 4; ++j) { const int n = (lane >> 3) + 8 * j; const LAS float* s = scr + (8 * c) * 33 + n;
        v4u o; o.x = pk2(s[0 * 33], s[1 * 33]); o.y = pk2(s[2 * 33], s[3 * 33]); o.z = pk2(s[4 * 33], s[5 * 33]); o.w = pk2(s[6 * 33], s[7 * 33]);
        *(v4u*)(WT + (size_t)(row_off + n0 + n) * K + k0 + 8 * c) = o; }
    asm volatile("s_waitcnt lgkmcnt(0)" ::: "memory");
}

__device__ __forceinline__ void p0_transpose64(const float* W, int K, int N, bf16* WT, LAS unsigned char* scr, int item, int lane) {
    const int nblk = N >> 6, kb = item / nblk, nb = item - kb * nblk, k0 = 64 * kb, n0 = 64 * nb;
    const int n4 = lane & 15, kq = lane >> 4;
    const float* src = W + (size_t)(k0 + 16 * kq) * N + n0 + 4 * n4;
    f32x4 v[16];
#pragma unroll
    for (int i = 0; i < 16; ++i) v[i] = *(const f32x4*)(src + (size_t)i * N);
#pragma unroll
    for (int e = 0; e < 4; ++e) { v4u lo, hi;
        lo.x = pk2(v[0][e], v[1][e]); lo.y = pk2(v[2][e], v[3][e]); lo.z = pk2(v[4][e], v[5][e]); lo.w = pk2(v[6][e], v[7][e]);
        hi.x = pk2(v[8][e], v[9][e]); hi.y = pk2(v[10][e], v[11][e]); hi.z = pk2(v[12][e], v[13][e]); hi.w = pk2(v[14][e], v[15][e]);
        LAS unsigned char* d = scr + (4 * n4 + e) * 144 + 32 * kq;
        *(LAS v4u*)d = lo; *(LAS v4u*)(d + 16) = hi; }
    asm volatile("s_waitcnt lgkmcnt(0)" ::: "memory");
#pragma unroll
    for (int j = 0; j < 8; ++j) { const int c = lane + 64 * j, n = c >> 3, kc = c & 7;
        const v4u o = *(const LAS v4u*)(scr + n * 144 + 16 * kc);
        *(v4u*)(WT + (size_t)(n0 + n) * K + k0 + 8 * kc) = o; }
    asm volatile("s_waitcnt lgkmcnt(0)" ::: "memory");
}

__device__ __forceinline__ void phase_prologue(const Params& p, unsigned char* lds) {
    FRESH_IDS();
    unsigned char* ws = p.ws;
    const int G = gridDim.x, bx = blockIdx.x;
    {
        float* sv = (float*)lds; float* red = (float*)(lds + 12288);
        for (int i = tid; i < 3072; i += NTHR) { const int r = i >> 10, k = i & 1023; const float xv = r < 2 ? p.c[r * 1024 + k] : p.c_ctx[k]; sv[i] = xv / (1.f + expf(-xv)); }
        __syncthreads();
        float* mod = (float*)(ws + WS_MOD);
        for (int item = bx; item < 384; item += G) {
            const int l = item / 96, col0 = (item % 96) * 64, tx = tid & 15, kg = tid >> 4;
            const float* W = p.ada_w + (size_t)l * 1024 * 6144 + col0 + tx * 4;
            f32x4 a0 = (f32x4){0.f, 0.f, 0.f, 0.f}, a1 = a0, a2 = a0;
#pragma unroll 8
            for (int kk = 0; kk < 32; ++kk) { const int k = kg * 32 + kk; const f32x4 w = *(const f32x4*)(W + (size_t)k * 6144); a0 += w * sv[k]; a1 += w * sv[1024 + k]; a2 += w * sv[2048 + k]; }
#pragma unroll
            for (int e = 0; e < 4; ++e) { red[(kg * 3 + 0) * 64 + tx * 4 + e] = a0[e]; red[(kg * 3 + 1) * 64 + tx * 4 + e] = a1[e]; red[(kg * 3 + 2) * 64 + tx * 4 + e] = a2[e]; }
            __syncthreads();
            if (tid < 192) { const int r = tid >> 6, ci = tid & 63; float s = 0.f;
                for (int g = 0; g < 32; ++g) s += red[(g * 3 + r) * 64 + ci];
                mod[(l * 3 + r) * 6144 + col0 + ci] = s + p.ada_b[l * 6144 + col0 + ci]; }
            __syncthreads();
        }
    }
    {
        const int gi = bx * NTHR + tid;
        if (gi < 2048) { const int pos = gi >> 4, i = gi & 15;
            const float invf = exp2f(-(float)i * (13.287712379549449f / 16.f));
            const float ang = (float)pos * invf;
            const double rev = (double)ang * 0.15915494309189535; const double fr = rev - rint(rev);
            float* ct = (float*)(ws + WS_ROPE); float* st = ct + 2048;
            ct[gi] = __builtin_amdgcn_cosf((float)fr); st[gi] = __builtin_amdgcn_sinf((float)fr); }
    }
    {
        const size_t gt = (size_t)bx * NTHR + tid, GT = (size_t)G * NTHR;
        const f32x4* cs = (const f32x4*)p.ctx; f32x4* cd = (f32x4*)(ws + WS_HC);
        for (size_t i = gt; i < (size_t)(MT - ML) * D / 4; i += GT) cd[i] = cs[i];
    }
    __syncthreads();
    {
        LAS unsigned char* scr = (LAS unsigned char*)lds + wave * 16384;
        const int gw = bx * NWAVES + wave, NGW = G * NWAVES;
        constexpr int I_UP = (D / 64) * (FF / 64), I_DN = (FF / 64) * (D / 64), I_AIN = (D / 64) * (3072 / 64), I_GATE = (D / 64), I_SQ = (D / 64) * (D / 64), I_BQ = (D / 64) * (1536 / 64);
        constexpr int NITEMS = 4 * I_UP + 4 * I_DN + 2 * I_AIN + 2 * I_GATE + 2 * I_SQ + I_BQ + I_SQ + I_AIN + I_SQ;
        for (int it = gw; it < NITEMS; it += NGW) {
            int r = it; const float* W; bf16* WT; int K = D, N = D; bool gate = false;
            if (r < 4 * I_UP) { const int l = r / I_UP; W = p.mlp_w1 + (size_t)l * D * FF; N = FF; WT = (bf16*)(ws + WS_W1) + (size_t)l * D * FF; r %= I_UP; }
            else if ((r -= 4 * I_UP) < 4 * I_DN) { const int l = r / I_DN; W = p.mlp_w2 + (size_t)l * D * FF; K = FF; WT = (bf16*)(ws + WS_W2) + (size_t)l * D * FF; r %= I_DN; }
            else if ((r -= 4 * I_DN) < 2 * I_AIN) { const int l = r / I_AIN; W = p.a_w_in + (size_t)l * D * 3072; N = 3072; WT = (bf16*)(ws + WS_AIN) + (size_t)l * 3328 * D; r %= I_AIN; }
            else if ((r -= 2 * I_AIN) < 2 * I_GATE) { const int l = r / I_GATE; W = p.a_w_gate + (size_t)l * D * 32; N = 32; WT = (bf16*)(ws + WS_AIN) + (size_t)l * 3328 * D; gate = true; r %= I_GATE; }
            else if ((r -= 2 * I_GATE) < 2 * I_SQ) { const int l = r / I_SQ; W = p.a_w_out + (size_t)l * D * D; WT = (bf16*)(ws + WS_AOUT) + (size_t)l * D * D; r %= I_SQ; }
            else if ((r -= 2 * I_SQ) < I_BQ) { W = p.b_w_qkv; N = 1536; WT = (bf16*)(ws + WS_BQKV); }
            else if ((r -= I_BQ) < I_SQ) { W = p.b_w_out; WT = (bf16*)(ws + WS_BOUT); }
            else if ((r -= I_SQ) < I_AIN) { W = p.c_w_in; N = 3072; WT = (bf16*)(ws + WS_CIN); }
            else { r -= I_AIN; W = p.c_w_out; WT = (bf16*)(ws + WS_COUT); }
            if (gate) p0_transpose_item(W, K, N, WT, 3072, (LAS float*)scr, r, lane);
            else p0_transpose64(W, K, N, WT, scr, r, lane);
        }
    }
}

__device__ __forceinline__ void phase_norm(const Params& p, const float* hlat, int nrows, const float* g, const float* shift, const float* scale, int nparts) {
    FRESH_IDS();
    const int gw = blockIdx.x * NWAVES + wave, NGW = gridDim.x * NWAVES;
    float* hc = (float*)(p.ws + WS_HC); bf16* xn = (bf16*)(p.ws + WS_XN);
    for (int row0 = gw; row0 < nrows; row0 += 2 * NGW) {
        const int row1 = row0 + NGW; const bool has1 = row1 < nrows; const int rowb = has1 ? row1 : row0;
        const float* src0 = row0 < ML ? hlat + (size_t)row0 * D : hc + (size_t)(row0 - ML) * D;
        const float* src1 = rowb < ML ? hlat + (size_t)rowb * D : hc + (size_t)(rowb - ML) * D;
        const f32x4* xr0 = (const f32x4*)src0 + lane; const f32x4* xr1 = (const f32x4*)src1 + lane;
        f32x4 v0[4], v1[4]; float s0 = 0.f, s1 = 0.f;
#pragma unroll
        for (int j = 0; j < 4; ++j) { v0[j] = xr0[64 * j]; v1[j] = xr1[64 * j]; }
        if (nparts > 0) {
            const float* part = (const float*)(p.ws + WS_PART);
            if (row0 >= ML) { f32x4* hw = (f32x4*)(hc + (size_t)(row0 - ML) * D) + lane;
                for (int k = 0; k < nparts; ++k) { const f32x4* pr = (const f32x4*)(part + ((size_t)k * 512 + (row0 - ML)) * D) + lane;
#pragma unroll
                    for (int j = 0; j < 4; ++j) v0[j] += pr[64 * j]; }
#pragma unroll
                for (int j = 0; j < 4; ++j) hw[64 * j] = v0[j]; }
            if (has1 && row1 >= ML) { f32x4* hw = (f32x4*)(hc + (size_t)(row1 - ML) * D) + lane;
                for (int k = 0; k < nparts; ++k) { const f32x4* pr = (const f32x4*)(part + ((size_t)k * 512 + (row1 - ML)) * D) + lane;
#pragma unroll
                    for (int j = 0; j < 4; ++j) v1[j] += pr[64 * j]; }
#pragma unroll
                for (int j = 0; j < 4; ++j) hw[64 * j] = v1[j]; }
        }
#pragma unroll
        for (int j = 0; j < 4; ++j) { s0 += (v0[j].x * v0[j].x + v0[j].y * v0[j].y) + (v0[j].z * v0[j].z + v0[j].w * v0[j].w); s1 += (v1[j].x * v1[j].x + v1[j].y * v1[j].y) + (v1[j].z * v1[j].z + v1[j].w * v1[j].w); }
        const float rs0 = __builtin_amdgcn_rsqf(wave_sum(s0, lane) * (1.f / D) + 1e-6f), rs1 = __builtin_amdgcn_rsqf(wave_sum(s1, lane) * (1.f / D) + 1e-6f);
        const int r0 = row0 < ML ? (row0 >> 13) : 2, r1 = rowb < ML ? (rowb >> 13) : 2;
        unsigned long long* o0 = (unsigned long long*)(xn + (size_t)row0 * D) + lane; unsigned long long* o1 = (unsigned long long*)(xn + (size_t)rowb * D) + lane;
#pragma unroll
        for (int j = 0; j < 4; ++j) { const int col = 4 * lane + 256 * j;
            const f32x4 gg = *(const f32x4*)(g + col);
            { const f32x4 sh = *(const f32x4*)(shift + r0 * 6144 + col), sc = *(const f32x4*)(scale + r0 * 6144 + col);
              const f32x4 y = (v0[j] * rs0) * gg * (sc + 1.0f) + sh;
              o0[64 * j] = (unsigned long long)pk2(y.x, y.y) | ((unsigned long long)pk2(y.z, y.w) << 32); }
            if (has1) { const f32x4 sh = *(const f32x4*)(shift + r1 * 6144 + col), sc = *(const f32x4*)(scale + r1 * 6144 + col);
              const f32x4 y = (v1[j] * rs1) * gg * (sc + 1.0f) + sh;
              o1[64 * j] = (unsigned long long)pk2(y.x, y.y) | ((unsigned long long)pk2(y.z, y.w) << 32); }
        }
    }
}
__device__ __forceinline__ void phase_final_norm(const Params& p) {
    FRESH_IDS();
    const int gw = blockIdx.x * NWAVES + wave, NGW = gridDim.x * NWAVES;
    for (int row = gw; row < ML; row += NGW) {
        f32x4* xr = (f32x4*)(p.out + (size_t)row * D) + lane;
        f32x4 v[4]; float s = 0.f;
#pragma unroll
        for (int j = 0; j < 4; ++j) { v[j] = xr[64 * j]; s += (v[j].x * v[j].x + v[j].y * v[j].y) + (v[j].z * v[j].z + v[j].w * v[j].w); }
        const float rs = __builtin_amdgcn_rsqf(wave_sum(s, lane) * (1.f / D) + 1e-6f);
#pragma unroll
        for (int j = 0; j < 4; ++j) { const f32x4 gg = *(const f32x4*)(p.final_g + 4 * lane + 256 * j); xr[64 * j] = (v[j] * rs) * gg; }
    }
}

__device__ __forceinline__ void phase_conv(const Params& p, int nrows) {
    FRESH_IDS();
    const bf16* P = (const bf16*)(p.ws + WS_ACT); bf16* Z = (bf16*)(p.ws + WS_HG);
    const int gt = blockIdx.x * NTHR + tid, GT = gridDim.x * NTHR;
    const int ch = (gt & 127) * 8;
    f32x4 cw[3][2], cb[2];
#pragma unroll
    for (int h = 0; h < 2; ++h) { cb[h] = *(const f32x4*)(p.c_conv_b + ch + 4 * h);
#pragma unroll
        for (int w = 0; w < 3; ++w) cw[w][h] = *(const f32x4*)(p.c_conv_w + w * 1024 + ch + 4 * h); }
    for (int q = gt >> 7; q < nrows / 4; q += GT >> 7) {
        const int row0 = 4 * q;
        bool hp, hn;
        if (row0 < ML) { const int s0 = row0 & (SEQ - 1); hp = s0 > 0; hn = s0 + 4 < SEQ; } else { const int t0 = (row0 - ML) & (CTXL - 1); hp = t0 > 0; hn = t0 + 4 < CTXL; }
        const bf16* pr = P + (size_t)row0 * 3072 + ch;
        v4u cg[6], xt[6], bgv[4];
#pragma unroll
        for (int i = 0; i < 6; ++i) { const bool ok = (i == 0) ? hp : ((i == 5) ? hn : true);
            if (ok) { cg[i] = *(const v4u*)(pr + (ptrdiff_t)(i - 1) * 3072 + 1024); xt[i] = *(const v4u*)(pr + (ptrdiff_t)(i - 1) * 3072 + 2048); }
            else { cg[i] = (v4u){0u, 0u, 0u, 0u}; xt[i] = cg[i]; } }
#pragma unroll
        for (int i = 0; i < 4; ++i) bgv[i] = *(const v4u*)(pr + (size_t)i * 3072);
        float u[6][8];
#pragma unroll
        for (int i = 0; i < 6; ++i)
#pragma unroll
            for (int e2 = 0; e2 < 4; ++e2) { u[i][2 * e2] = bflo(cg[i][e2]) * bflo(xt[i][e2]); u[i][2 * e2 + 1] = bfhi(cg[i][e2]) * bfhi(xt[i][e2]); }
#pragma unroll
        for (int i = 0; i < 4; ++i) { v4u o;
#pragma unroll
            for (int e2 = 0; e2 < 4; ++e2) { const int e = 2 * e2, h = e >> 2, k = e & 3;
                const float a0 = cb[h][k] + cw[0][h][k] * u[i][e] + cw[1][h][k] * u[i + 1][e] + cw[2][h][k] * u[i + 2][e];
                const float a1 = cb[h][k + 1] + cw[0][h][k + 1] * u[i][e + 1] + cw[1][h][k + 1] * u[i + 1][e + 1] + cw[2][h][k + 1] * u[i + 2][e + 1];
                o[e2] = pk2(bflo(bgv[i][e2]) * a0, bfhi(bgv[i][e2]) * a1); }
            *(v4u*)(Z + (size_t)(row0 + i) * 1024 + ch) = o; }
    }
}

__device__ __forceinline__ void mlstm_scan(const float* lf, const float* li, float* bo, float* gso, float* mco, float mprev, bool bwd, int lane) {
    const int i0 = bwd ? 127 - 2 * lane : 2 * lane, i1 = bwd ? 126 - 2 * lane : 2 * lane + 1;
    const float a0 = lf[i0], a1 = lf[i1];
    float s = a0 + a1;
#pragma unroll
    for (int o = 1; o < 64; o <<= 1) { const float t = shup(s, o, lane); if (lane >= o) s += t; }
    const float b0 = s - a1, b1 = s;
    bo[i0] = b0; bo[i1] = b1;
    const float g0 = li[i0] - b0, g1 = li[i1] - b1;
    if (gso) { gso[i0] = g0; gso[i1] = g1; }
    if (mco) {
        float pm = fmaxf(g0, g1);
#pragma unroll
        for (int o = 1; o < 64; o <<= 1) { const float t = shup(pm, o, lane); if (lane >= o) pm = fmaxf(pm, t); }
        float pe = shup(pm, 1, lane); if (lane == 0) pe = NEG_BIG;
        const float m0 = fmaxf(pe, g0), m1 = fmaxf(m0, g1);
        mco[i0] = b0 + fmaxf(mprev, m0); mco[i1] = b1 + fmaxf(mprev, m1);
    }
}

__device__ __forceinline__ void phase_mlstm_local(const Params& p, unsigned char* lds) {
    FRESH_IDS();
    const bf16* P = (const bf16*)(p.ws + WS_ACT); const float* Gt = (const float*)(p.ws + WS_G);
    float* dC = (float*)(p.ws + WS_DC); float* dN = (float*)(p.ws + WS_DN);
    float* mloc = (float*)(p.ws + WS_MISC); float* bend = mloc + 32 * NCH;
    bf16* Vt = (bf16*)lds; bf16* Ktf = (bf16*)(lds + 34816); bf16* Ktb = (bf16*)(lds + 52224);
    float* fl = (float*)(lds + 69632);
    float *lif = fl, *lff = fl + 128, *lib = fl + 256, *lfb = fl + 384, *bfw = fl + 512, *bbw = fl + 640, *wsf = fl + 768, *wsb = fl + 896;
    const int fr = lane & 15, fq = lane >> 4;
    for (int item = blockIdx.x; item < NBATCH * 8 * NCH; item += gridDim.x) {
        int tix = tid; asm volatile("" : "+v"(tix));
        const int b = item / (8 * NCH), hd = (item / NCH) % 8, j = item % NCH;
        const int row0 = chunk_row(b, j);
        const int chain0 = (b * 8 + hd) * 2;
        int ll = tix & 63; const int fr = ll & 15, fq = ll >> 4;
        __syncthreads();
        if (tix < 128) { const float* g = Gt + (size_t)(row0 + tix) * 32; lif[tix] = g[hd]; lff[tix] = logsig(g[8 + hd]); lib[tix] = g[16 + hd]; lfb[tix] = logsig(g[24 + hd]); }
        __syncthreads();
        if (wave < 2) {
            const bool bw = wave == 1;
            mlstm_scan(bw ? lfb : lff, bw ? lib : lif, bw ? bbw : bfw, nullptr, nullptr, 0.f, bw, lane);
            asm volatile("s_waitcnt lgkmcnt(0)" ::: "memory");
            const float* bb_ = bw ? bbw : bfw; const float* li_ = bw ? lib : lif; float* ws_ = bw ? wsb : wsf;
            const float be = bw ? bb_[0] : bb_[127];
            const float w0 = be - bb_[lane] + li_[lane], w1 = be - bb_[lane + 64] + li_[lane + 64];
            const float mx = wave_max(fmaxf(w0, w1), lane);
            ws_[lane] = __expf(w0 - mx); ws_[lane + 64] = __expf(w1 - mx);
            if (lane == 0) { mloc[(chain0 + wave) * NCH + j] = mx; bend[(chain0 + wave) * NCH + j] = be; }
        }
        __syncthreads();
        for (int c = tix; c < 2048; c += NTHR) { const int s = c & 127, ch = c >> 7;
            const v4u v = *(const v4u*)(P + (size_t)(row0 + s) * 3072 + 1024 + hd * 128 + ch * 8);
#pragma unroll
            for (int e2 = 0; e2 < 4; ++e2) { Vt[(ch * 8 + 2 * e2) * 136 + s] = (bf16)(v[e2] & 0xffffu); Vt[(ch * 8 + 2 * e2 + 1) * 136 + s] = (bf16)(v[e2] >> 16); } }
        for (int c = tix; c < 1024; c += NTHR) { const int s = c & 127, ch = c >> 7;
            const v4u v = *(const v4u*)(P + (size_t)(row0 + s) * 3072 + 512 + hd * 64 + ch * 8);
            const float wf = wsf[s], wb = wsb[s];
#pragma unroll
            for (int e2 = 0; e2 < 4; ++e2) { const float k0 = bflo(v[e2]), k1 = bfhi(v[e2]);
                const unsigned pf_ = pk2(k0 * wf, k1 * wf), pb_ = pk2(k0 * wb, k1 * wb);
                Ktf[(ch * 8 + 2 * e2) * 136 + s] = (bf16)(pf_ & 0xffffu); Ktf[(ch * 8 + 2 * e2 + 1) * 136 + s] = (bf16)(pf_ >> 16);
                Ktb[(ch * 8 + 2 * e2) * 136 + s] = (bf16)(pb_ & 0xffffu); Ktb[(ch * 8 + 2 * e2 + 1) * 136 + s] = (bf16)(pb_ >> 16); } }
        __syncthreads();
#pragma unroll
        for (int dir = 0; dir < 2; ++dir) {
            const bf16* Kt = dir ? Ktb : Ktf;
            f32x4 acc[4];
#pragma unroll
            for (int nt = 0; nt < 4; ++nt) acc[nt] = (f32x4){0.f, 0.f, 0.f, 0.f};
#pragma unroll
            for (int ks = 0; ks < 4; ++ks) { const bf16x8 a = *(const bf16x8*)(Vt + (16 * wave + fr) * 136 + 32 * ks + 8 * fq);
#pragma unroll
                for (int nt = 0; nt < 4; ++nt) { const bf16x8 bb = *(const bf16x8*)(Kt + (16 * nt + fr) * 136 + 32 * ks + 8 * fq); acc[nt] = MFMA16(a, bb, acc[nt]); } }
            float* dst = dC + ((size_t)(chain0 + dir) * NCH + j) * 8192;
#pragma unroll
            for (int nt = 0; nt < 4; ++nt)
#pragma unroll
                for (int r = 0; r < 4; ++r) dst[(16 * wave + 4 * fq + r) * 64 + 16 * nt + fr] = acc[nt][r];
        }
        if (tix < 128) { const int dir = tix >> 6, dk = tix & 63; const bf16* Kt = (dir ? Ktb : Ktf) + dk * 136; float s = 0.f;
            for (int i = 0; i < 128; ++i) s += bf2f(Kt[i]);
            dN[((size_t)(chain0 + dir) * NCH + j) * 64 + dk] = s; }
    }
}

__device__ __forceinline__ void phase_mlstm_scan(const Params& p) {
    FRESH_IDS();
    const float* dC = (const float*)(p.ws + WS_DC); float* dN = (float*)(p.ws + WS_DN); unsigned* CP = (unsigned*)(p.ws + WS_CP);
    const float* mloc = (const float*)(p.ws + WS_MISC); const float* bend = mloc + 32 * NCH; float* mprev = (float*)(p.ws + WS_MISC) + 2 * 32 * NCH;
    const int GT = gridDim.x * NTHR;
    for (int idx = blockIdx.x * NTHR + tid; idx < 32 * 4096; idx += GT) {
        const int chain = idx >> 12, e = idx & 4095, dir = chain & 1;
        const float2* src = (const float2*)(dC + (size_t)chain * NCH * 8192) + e;
        unsigned* dst = CP + (size_t)chain * NCH * 4096 + e;
        float2* nsrc = (float2*)(dN + (size_t)chain * NCH * 64) + e;
        const bool don = e < 32;
        float zz = 0.f; asm volatile("" : "+v"(zz));
        float m = NEG_BIG; float2 C = make_float2(zz, zz), n = make_float2(zz, zz);
        for (int pb = 0; pb < NCH; pb += 11) {
            float2 xv[11], nv[11]; float ml[11], be[11];
#pragma unroll
            for (int u = 0; u < 11; ++u) { const int pp = pb + u; const int j = dir ? (pp < 2 ? 1 - pp : 67 - pp) : pp;
                xv[u] = src[(size_t)j * 4096]; ml[u] = mloc[chain * NCH + j]; be[u] = bend[chain * NCH + j];
                nv[u] = don ? nsrc[j * 32] : make_float2(0.f, 0.f); }
#pragma unroll
            for (int u = 0; u < 11; ++u) { const int pp = pb + u; const int j = dir ? (pp < 2 ? 1 - pp : 67 - pp) : pp;
                dst[(size_t)j * 4096] = pk2(C.x, C.y);
                if (don) nsrc[j * 32] = n;
                if (e == 0) mprev[chain * NCH + j] = m;
                const float mn = fmaxf(be[u] + m, ml[u]);
                const float dcy = __expf(be[u] + m - mn), w = __expf(ml[u] - mn);
                C.x = dcy * C.x + w * xv[u].x; C.y = dcy * C.y + w * xv[u].y;
                n.x = dcy * n.x + w * nv[u].x; n.y = dcy * n.y + w * nv[u].y;
                m = mn; }
        }
    }
}

__device__ __forceinline__ void phase_mlstm_out(const Params& p, unsigned char* lds, int lyr_a, bool ctx_out) {
    FRESH_IDS();
    const bf16* P = (const bf16*)(p.ws + WS_ACT); const float* Gt = (const float*)(p.ws + WS_G);
    const float* nP = (const float*)(p.ws + WS_DN); const bf16* CP = (const bf16*)(p.ws + WS_CP);
    const float* mprev = (const float*)(p.ws + WS_MISC) + 2 * 32 * NCH;
    const float* head_g = p.a_head_g + lyr_a * 1024;
    bf16* HG = (bf16*)(p.ws + WS_HG);
    bf16* Qs = (bf16*)lds; bf16* Ks = (bf16*)(lds + 18432); bf16* Vt = (bf16*)(lds + 36864); bf16* Ct = (bf16*)(lds + 71680);
    float* fl = (float*)(lds + 106496);
    float *bfw = fl, *bbw = fl + 128, *gsf = fl + 256, *gsb = fl + 384, *mcf = fl + 512, *mcb = fl + 640, *lif = fl + 768, *lff = fl + 896, *lib = fl + 1024, *lfb = fl + 1152, *nf = fl + 1280, *nb = fl + 1344;
    const int fr = lane & 15, fq = lane >> 4;
    const int jlo = ctx_out ? 0 : 2, nj = NCH - jlo;
    const int nitems = NBATCH * 8 * nj;
    v4u rq[2], rk[2], rv[4], rc[4]; float rg0 = 0.f, rg1 = 0.f, rg2 = 0.f, rg3 = 0.f, rn = 0.f, rmf = 0.f, rmb = 0.f;
#define P5_PREFETCH(it_) do { const int b_ = (it_) / (8 * nj), hd_ = ((it_) / nj) % 8, j_ = jlo + (it_) % nj; const int row0_ = chunk_row(b_, j_), chain0_ = (b_ * 8 + hd_) * 2; \
        rmf = mprev[(chain0_ + 0) * NCH + j_]; rmb = mprev[(chain0_ + 1) * NCH + j_]; \
        if (tix < 128) { const float* g_ = Gt + (size_t)(row0_ + tix) * 32; rg0 = g_[hd_]; rg1 = g_[8 + hd_]; rg2 = g_[16 + hd_]; rg3 = g_[24 + hd_]; \
            rn = nP[((size_t)(chain0_ + (tix >> 6)) * NCH + j_) * 64 + (tix & 63)]; } \
        _Pragma("unroll") for (int i = 0; i < 2; ++i) { const int c = tix + i * NTHR, r = c >> 3, ch = c & 7; \
            rq[i] = *(const v4u*)(P + (size_t)(row0_ + r) * 3072 + hd_ * 64 + ch * 8); rk[i] = *(const v4u*)(P + (size_t)(row0_ + r) * 3072 + 512 + hd_ * 64 + ch * 8); } \
        _Pragma("unroll") for (int i = 0; i < 4; ++i) { const int c = tix + i * NTHR; \
            rv[i] = *(const v4u*)(P + (size_t)(row0_ + (c & 127)) * 3072 + 1024 + hd_ * 128 + (c >> 7) * 8); \
            rc[i] = *(const v4u*)(CP + ((size_t)(chain0_ + (c >> 10)) * NCH + j_) * 8192 + ((c >> 3) & 127) * 64 + (c & 7) * 8); } } while (0)
    { int tix = tid; asm volatile("" : "+v"(tix)); if ((int)blockIdx.x < nitems) P5_PREFETCH((int)blockIdx.x); }
    for (int item = blockIdx.x; item < nitems; item += gridDim.x) {
        int tix = tid; asm volatile("" : "+v"(tix));
        const int b = item / (8 * nj), hd = (item / nj) % 8, j = jlo + item % nj;
        const int row0 = chunk_row(b, j);
        const int chain0 = (b * 8 + hd) * 2;
        int ll = tix & 63; const int fr = ll & 15, fq = ll >> 4;
        const float m_f = rmf, m_b = rmb;
        asm volatile("s_waitcnt lgkmcnt(0)" ::: "memory"); __builtin_amdgcn_s_barrier(); asm volatile("" ::: "memory");
        if (tix < 128) { lif[tix] = rg0; lff[tix] = logsig(rg1); lib[tix] = rg2; lfb[tix] = logsig(rg3); ((tix >> 6) ? nb : nf)[tix & 63] = rn; }
#pragma unroll
        for (int i = 0; i < 2; ++i) { const int c = tix + i * NTHR, r = c >> 3, ch = c & 7;
            *(v4u*)(Qs + r * 72 + ch * 8) = rq[i]; *(v4u*)(Ks + r * 72 + ch * 8) = rk[i]; }
#pragma unroll
        for (int i = 0; i < 4; ++i) { const int c = tix + i * NTHR; const int s = c & 127, ch = c >> 7; const v4u v = rv[i];
#pragma unroll
            for (int e2 = 0; e2 < 4; ++e2) { Vt[(ch * 8 + 2 * e2) * 136 + s] = (bf16)(v[e2] & 0xffffu); Vt[(ch * 8 + 2 * e2 + 1) * 136 + s] = (bf16)(v[e2] >> 16); }
            const int dir = c >> 10, dv = (c >> 3) & 127, ch2 = c & 7;
            *(v4u*)(Ct + dv * 136 + dir * 64 + ch2 * 8) = rc[i]; }
        asm volatile("s_waitcnt lgkmcnt(0)" ::: "memory"); __builtin_amdgcn_s_barrier(); asm volatile("" ::: "memory");
        if (wave == 0) mlstm_scan(lff, lif, bfw, gsf, mcf, m_f, false, lane);
        else if (wave == 1) mlstm_scan(lfb, lib, bbw, gsb, mcb, m_b, true, lane);
        asm volatile("s_waitcnt lgkmcnt(0)" ::: "memory"); __builtin_amdgcn_s_barrier(); asm volatile("" ::: "memory");
        if (item + (int)gridDim.x < nitems) P5_PREFETCH(item + (int)gridDim.x);
        const int t = 16 * wave + fr;
        const float btf = bfw[t], mcft = mcf[t], btb = bbw[t], mcbt = mcb[t];
        const float af = __expf(btf + m_f - mcft), ab = __expf(btb + m_b - mcbt);
        float qnf = 0.f, qnb = 0.f;
#pragma unroll
        for (int i = 0; i < 16; ++i) { const int dk = 16 * fq + i; const float qv = bf2f(Qs[t * 72 + dk]); qnf += qv * nf[dk]; qnb += qv * nb[dk]; }
        qnf += shx(qnf, 16, ll); qnf += shx(qnf, 32, ll); qnb += shx(qnb, 16, ll); qnb += shx(qnb, 32, ll);
        qnf *= 0.125f; qnb *= 0.125f;
        bf16x8 bq[2];
#pragma unroll
        for (int ks = 0; ks < 2; ++ks) bq[ks] = *(const bf16x8*)(Qs + t * 72 + 32 * ks + 8 * fq);
        f32x4 scf[8], scb[8]; float sumf = 0.f, sumb = 0.f;
#pragma unroll
        for (int st = 0; st < 8; ++st) {
            f32x4 acc = (f32x4){0.f, 0.f, 0.f, 0.f};
#pragma unroll
            for (int ks = 0; ks < 2; ++ks) { const bf16x8 a = *(const bf16x8*)(Ks + (16 * st + fr) * 72 + 32 * ks + 8 * fq); acc = MFMA16(a, bq[ks], acc); }
            const f32x4 gf4 = *(const f32x4*)(gsf + 16 * st + 4 * fq), gb4 = *(const f32x4*)(gsb + 16 * st + 4 * fq);
#pragma unroll
            for (int r = 0; r < 4; ++r) { const int s = 16 * st + 4 * fq + r; const float sv = acc[r] * 0.125f;
                const float df = (s <= t) ? __expf(btf + gf4[r] - mcft) : 0.f, db = (s >= t) ? __expf(btb + gb4[r] - mcbt) : 0.f;
                scf[st][r] = sv * df; scb[st][r] = sv * db; sumf += scf[st][r]; sumb += scb[st][r]; }
        }
        sumf += shx(sumf, 16, ll); sumf += shx(sumf, 32, ll); sumb += shx(sumb, 16, ll); sumb += shx(sumb, 32, ll);
        const float rf = __builtin_amdgcn_rcpf(fmaxf(fabsf(sumf + af * qnf), __expf(-mcft))), rb = __builtin_amdgcn_rcpf(fmaxf(fabsf(sumb + ab * qnb), __expf(-mcbt)));
        bf16x8 pf[4], qf[4];
#pragma unroll
        for (int kp = 0; kp < 4; ++kp) { v4u w;
            w.x = pk2(scf[2 * kp][0] * rf + scb[2 * kp][0] * rb, scf[2 * kp][1] * rf + scb[2 * kp][1] * rb);
            w.y = pk2(scf[2 * kp][2] * rf + scb[2 * kp][2] * rb, scf[2 * kp][3] * rf + scb[2 * kp][3] * rb);
            w.z = pk2(scf[2 * kp + 1][0] * rf + scb[2 * kp + 1][0] * rb, scf[2 * kp + 1][1] * rf + scb[2 * kp + 1][1] * rb);
            w.w = pk2(scf[2 * kp + 1][2] * rf + scb[2 * kp + 1][2] * rb, scf[2 * kp + 1][3] * rf + scb[2 * kp + 1][3] * rb);
            pf[kp] = __builtin_bit_cast(bf16x8, w); }
#pragma unroll
        for (int ks = 0; ks < 4; ++ks) { const float scl = 0.125f * ((ks >> 1) ? ab * rb : af * rf);
            const v4u qr = *(const v4u*)(Qs + t * 72 + 32 * (ks & 1) + 8 * fq); v4u w;
#pragma unroll
            for (int e2 = 0; e2 < 4; ++e2) w[e2] = pk2(bflo(qr[e2]) * scl, bfhi(qr[e2]) * scl);
            qf[ks] = __builtin_bit_cast(bf16x8, w); }
        const size_t row = (size_t)(row0 + t);
        v2u ovp[8];
#pragma unroll
        for (int dt = 0; dt < 8; ++dt) ovp[dt] = *(const v2u*)(P + row * 3072 + 2048 + hd * 128 + 16 * dt + 4 * fq);
        f32x4 hacc[8]; float ss = 0.f;
#pragma unroll
        for (int dt = 0; dt < 8; ++dt) {
            f32x4 acc = (f32x4){0.f, 0.f, 0.f, 0.f};
#pragma unroll
            for (int kp = 0; kp < 4; ++kp) { v4u aw; const v2u lo = *(const v2u*)(Vt + (16 * dt + fr) * 136 + 32 * kp + 4 * fq), hi = *(const v2u*)(Vt + (16 * dt + fr) * 136 + 32 * kp + 16 + 4 * fq);
                aw.x = lo.x; aw.y = lo.y; aw.z = hi.x; aw.w = hi.y; acc = MFMA16(__builtin_bit_cast(bf16x8, aw), pf[kp], acc); }
#pragma unroll
            for (int ks = 0; ks < 4; ++ks) { const bf16x8 a = *(const bf16x8*)(Ct + (16 * dt + fr) * 136 + 32 * ks + 8 * fq); acc = MFMA16(a, qf[ks], acc); }
            hacc[dt] = acc; ss += (acc[0] * acc[0] + acc[1] * acc[1]) + (acc[2] * acc[2] + acc[3] * acc[3]);
        }
        ss += shx(ss, 16, ll); ss += shx(ss, 32, ll);
        const float rn = __builtin_amdgcn_rsqf(ss * (1.f / 128.f) + 1e-6f);
#pragma unroll
        for (int dt = 0; dt < 8; ++dt) { const int dv0 = 16 * dt + 4 * fq;
            const v2u ov = ovp[dt]; const f32x4 hg4 = *(const f32x4*)(head_g + hd * 128 + dv0);
            const float o0 = bflo(ov.x), o1 = bfhi(ov.x), o2 = bflo(ov.y), o3 = bfhi(ov.y);
            const float y0 = hacc[dt][0] * rn * hg4[0] * __builtin_amdgcn_rcpf(1.f + __expf(-o0)), y1 = hacc[dt][1] * rn * hg4[1] * __builtin_amdgcn_rcpf(1.f + __expf(-o1));
            const float y2 = hacc[dt][2] * rn * hg4[2] * __builtin_amdgcn_rcpf(1.f + __expf(-o2)), y3 = hacc[dt][3] * rn * hg4[3] * __builtin_amdgcn_rcpf(1.f + __expf(-o3));
            v2u w; w.x = pk2(y0, y1); w.y = pk2(y2, y3);
            *(v2u*)(HG + row * 1024 + hd * 128 + dv0) = w; }
    }
}

#undef P5_PREFETCH
__device__ __forceinline__ void phase_attn(const Params& p, unsigned char* lds, bool ctx_out) {
    FRESH_IDS();
    const bf16* Pq = (const bf16*)(p.ws + WS_ACT); bf16* AO = (bf16*)(p.ws + WS_HG);
    bf16* Ks = (bf16*)lds; bf16* Vt = (bf16*)(lds + 18432);
    const int fr = lane & 15, fq = lane >> 4;
    const int nitems = 512 + (ctx_out ? 16 : 0);
    const int vb0 = ((int)gridDim.x & 7) == 0 ? ((int)blockIdx.x & 7) * ((int)gridDim.x >> 3) + ((int)blockIdx.x >> 3) : (int)blockIdx.x;
    for (int item = vb0; item < nitems; item += gridDim.x) {
        int tix = tid; asm volatile("" : "+v"(tix));
        int b, g, qrow0, nblk = 0; bool lat = item < 512;
        if (lat) { b = item >> 8; g = (item >> 6) & 3; nblk = item & 63; qrow0 = b * SEQ + nblk * 128; }
        else { const int ci = item - 512; b = ci >> 3; g = (ci >> 1) & 3; qrow0 = ML + b * CTXL + (ci & 1) * 128; }
        const int hq = g * 4 + (wave >> 1), tbase = (wave & 1) * 64;
        const float sink = p.b_sinks[hq] * 1.4426950408889634f;
        unsigned char* Qw = lds + 36864 + wave * 8192;
        { const int l0 = tix & 63, fr0 = l0 & 15, fq0 = l0 >> 4;
#pragma unroll
          for (int tt = 0; tt < 4; ++tt)
#pragma unroll
              for (int ks = 0; ks < 2; ++ks) *(v4u*)(Qw + ((tt * 2 + ks) * 64 + l0) * 16) = *(const v4u*)(Pq + (size_t)(qrow0 + tbase + 16 * tt + fr0) * 1536 + hq * 64 + 32 * ks + 8 * fq0); }
        float mrun[4], lrun[4]; f32x4 oacc[4][4];
#pragma unroll
        for (int tt = 0; tt < 4; ++tt) { mrun[tt] = sink; lrun[tt] = (fq == 0) ? 1.f : 0.f;
#pragma unroll
            for (int dt = 0; dt < 4; ++dt) oacc[tt][dt] = (f32x4){0.f, 0.f, 0.f, 0.f}; }
        for (int c = 0; c < 5; ++c) {
            int krow0, mtype = 0;
            if (lat) {
                if (c == 0) { if (nblk == 0) continue; krow0 = qrow0 - 128; mtype = 1; }
                else if (c == 1) { krow0 = qrow0; }
                else if (c == 2) { if (nblk == 63) continue; krow0 = qrow0 + 128; mtype = 2; }
                else { krow0 = ML + b * CTXL + (c - 3) * 128; }
            } else { if (c < 3) continue; krow0 = ML + b * CTXL + (c - 3) * 128; }
            __syncthreads();
            int ll = tix & 63; asm volatile("" : "+v"(ll)); const int fr = ll & 15, fq = ll >> 4;
            for (int cc = tix; cc < 1024; cc += NTHR) { const int r = cc >> 3, ch = cc & 7;
                *(v4u*)(Ks + r * 72 + ch * 8) = *(const v4u*)(Pq + (size_t)(krow0 + r) * 1536 + 1024 + g * 64 + ch * 8); }
            for (int cc = tix; cc < 1024; cc += NTHR) { const int s = cc & 127, ch = cc >> 7;
                const v4u v = *(const v4u*)(Pq + (size_t)(krow0 + s) * 1536 + 1280 + g * 64 + ch * 8);
#pragma unroll
                for (int e2 = 0; e2 < 4; ++e2) { Vt[(ch * 8 + 2 * e2) * 136 + s] = (bf16)(v[e2] & 0xffffu); Vt[(ch * 8 + 2 * e2 + 1) * 136 + s] = (bf16)(v[e2] >> 16); } }
            __syncthreads();
#pragma unroll
            for (int tp = 0; tp < 2; ++tp) {
                bf16x8 bq[2][2]; f32x4 sa[2][8]; float mx[2] = {NEG_BIG, NEG_BIG};
#pragma unroll
                for (int h = 0; h < 2; ++h)
#pragma unroll
                    for (int ks = 0; ks < 2; ++ks) bq[h][ks] = *(const bf16x8*)(Qw + (((2 * tp + h) * 2 + ks) * 64 + ll) * 16);
#pragma unroll
                for (int st = 0; st < 8; ++st) {
                    bool dead[2];
#pragma unroll
                    for (int h = 0; h < 2; ++h) { const int q0 = tbase + 16 * (2 * tp + h); dead[h] = (mtype == 1) ? (16 * st + 15 < q0) : ((mtype == 2) ? (16 * st > q0 + 15) : false); }
                    if (dead[0] && dead[1]) { sa[0][st] = (f32x4){NEG_BIG, NEG_BIG, NEG_BIG, NEG_BIG}; sa[1][st] = sa[0][st]; continue; }
                    bf16x8 kf[2];
#pragma unroll
                    for (int ks = 0; ks < 2; ++ks) kf[ks] = *(const bf16x8*)(Ks + (16 * st + fr) * 72 + 32 * ks + 8 * fq);
#pragma unroll
                    for (int h = 0; h < 2; ++h) {
                        if (dead[h]) { sa[h][st] = (f32x4){NEG_BIG, NEG_BIG, NEG_BIG, NEG_BIG}; continue; }
                        f32x4 acc = (f32x4){0.f, 0.f, 0.f, 0.f};
#pragma unroll
                        for (int ks = 0; ks < 2; ++ks) acc = MFMA16(kf[ks], bq[h][ks], acc);
                        if (mtype != 0) { const int t = tbase + 16 * (2 * tp + h) + fr;
#pragma unroll
                            for (int r = 0; r < 4; ++r) { const int d = (16 * st + 4 * fq + r) - t;
                                const bool ok = (mtype == 1) ? (d >= 0) : (d <= 0);
                                acc[r] = ok ? acc[r] : NEG_BIG; } }
                        mx[h] = fmaxf(fmaxf(mx[h], fmaxf(acc[0], acc[1])), fmaxf(acc[2], acc[3]));
                        sa[h][st] = acc;
                    }
                }
                bf16x8 pf[2][4]; float alpha[2];
#pragma unroll
                for (int h = 0; h < 2; ++h) { const int tt = 2 * tp + h;
                    float m_ = mx[h]; m_ = fmaxf(m_, shx(m_, 16, ll)); m_ = fmaxf(m_, shx(m_, 32, ll));
                    const float mn = fmaxf(mrun[tt], m_); alpha[h] = __builtin_amdgcn_exp2f(mrun[tt] - mn);
                    float ls = 0.f;
#pragma unroll
                    for (int st = 0; st < 8; ++st) {
                        const int q0 = tbase + 16 * tt;
                        const bool dead_ = (mtype == 1) ? (16 * st + 15 < q0) : ((mtype == 2) ? (16 * st > q0 + 15) : false);
                        if (dead_) { sa[h][st] = (f32x4){0.f, 0.f, 0.f, 0.f}; continue; }
#pragma unroll
                        for (int r = 0; r < 4; ++r) { const float pv = __builtin_amdgcn_exp2f(sa[h][st][r] - mn); sa[h][st][r] = pv; ls += pv; } }
                    lrun[tt] = lrun[tt] * alpha[h] + ls; mrun[tt] = mn;
#pragma unroll
                    for (int kp = 0; kp < 4; ++kp) { v4u w; w.x = pk2(sa[h][2 * kp][0], sa[h][2 * kp][1]); w.y = pk2(sa[h][2 * kp][2], sa[h][2 * kp][3]); w.z = pk2(sa[h][2 * kp + 1][0], sa[h][2 * kp + 1][1]); w.w = pk2(sa[h][2 * kp + 1][2], sa[h][2 * kp + 1][3]);
                        pf[h][kp] = __builtin_bit_cast(bf16x8, w); }
                }
#pragma unroll
                for (int dt = 0; dt < 4; ++dt) { f32x4 acc0 = oacc[2 * tp][dt] * alpha[0], acc1 = oacc[2 * tp + 1][dt] * alpha[1];
#pragma unroll
                    for (int kp = 0; kp < 4; ++kp) { v4u aw; const v2u lo = *(const v2u*)(Vt + (16 * dt + fr) * 136 + 32 * kp + 4 * fq), hi = *(const v2u*)(Vt + (16 * dt + fr) * 136 + 32 * kp + 16 + 4 * fq);
                        aw.x = lo.x; aw.y = lo.y; aw.z = hi.x; aw.w = hi.y; const bf16x8 vf = __builtin_bit_cast(bf16x8, aw);
                        acc0 = MFMA16(vf, pf[0][kp], acc0); acc1 = MFMA16(vf, pf[1][kp], acc1); }
                    oacc[2 * tp][dt] = acc0; oacc[2 * tp + 1][dt] = acc1; }
                __builtin_amdgcn_sched_barrier(0);
            }
        }
#pragma unroll
        for (int tt = 0; tt < 4; ++tt) { float lt = lrun[tt]; lt += shx(lt, 16, (tix & 63)); lt += shx(lt, 32, (tix & 63)); const float inv = 1.0f / lt;
            const size_t row = (size_t)(qrow0 + tbase + 16 * tt + fr);
#pragma unroll
            for (int dt = 0; dt < 4; ++dt) { v2u w; w.x = pk2(oacc[tt][dt][0] * inv, oacc[tt][dt][1] * inv); w.y = pk2(oacc[tt][dt][2] * inv, oacc[tt][dt][3] * inv);
                *(v2u*)(AO + row * 1024 + hq * 64 + 16 * dt + 4 * fq) = w; } }
    }
}


__device__ __forceinline__ void ctx_norm_part(const Params& p, const float* g, const float* shift, const float* scale, int nparts, unsigned* ctr) {
    FRESH_IDS();
    if (blockIdx.x < 64) {
        const int row = blockIdx.x * 8 + wave;
        float* hrow = (float*)(p.ws + WS_HC) + (size_t)row * D; bf16* xn = (bf16*)(p.ws + WS_XN) + (size_t)(ML + row) * D;
        const float* part = (const float*)(p.ws + WS_PART);
        f32x4* xr = (f32x4*)hrow + lane; f32x4 v[4];
#pragma unroll
        for (int j = 0; j < 4; ++j) v[j] = xr[64 * j];
        for (int k = 0; k < nparts; ++k) { const f32x4* pr = (const f32x4*)(part + ((size_t)k * 512 + row) * D) + lane;
#pragma unroll
            for (int j = 0; j < 4; ++j) v[j] += pr[64 * j]; }
        float s = 0.f;
#pragma unroll
        for (int j = 0; j < 4; ++j) { if (nparts > 0) xr[64 * j] = v[j]; s += (v[j].x * v[j].x + v[j].y * v[j].y) + (v[j].z * v[j].z + v[j].w * v[j].w); }
        const float rs = __builtin_amdgcn_rsqf(wave_sum(s, lane) * (1.f / D) + 1e-6f);
        unsigned long long* o8 = (unsigned long long*)xn + lane;
#pragma unroll
        for (int j = 0; j < 4; ++j) { const int col = 4 * lane + 256 * j;
            const f32x4 gg = *(const f32x4*)(g + col), sh = *(const f32x4*)(shift + 2 * 6144 + col), sc = *(const f32x4*)(scale + 2 * 6144 + col);
            const f32x4 y = (v[j] * rs) * gg * (sc + 1.0f) + sh;
            o8[64 * j] = (unsigned long long)pk2(y.x, y.y) | ((unsigned long long)pk2(y.z, y.w) << 32); }
        asm volatile("s_waitcnt vmcnt(0)" ::: "memory");
        __syncthreads();
        if (tid == 0) { __builtin_amdgcn_fence(__ATOMIC_RELEASE, "agent"); asm volatile("s_waitcnt vmcnt(0)" ::: "memory"); __hip_atomic_fetch_add(ctr, 1u, __ATOMIC_RELAXED, __HIP_MEMORY_SCOPE_AGENT); }
    }
}
__device__ __forceinline__ void ctx_wait(unsigned* ctr) {
    if (threadIdx.x == 0) { unsigned sp = 0;
        while (__hip_atomic_load(ctr, __ATOMIC_RELAXED, __HIP_MEMORY_SCOPE_AGENT) < 64u) { __builtin_amdgcn_s_sleep(2); if (++sp > (1u << 22)) break; }
        __builtin_amdgcn_fence(__ATOMIC_ACQUIRE, "agent"); asm volatile("s_waitcnt vmcnt(0)" ::: "memory"); }
    __syncthreads();
}

template <int MODE>
__device__ __forceinline__ void ctx_gemm(unsigned char* lds, const bf16* A, const bf16* Bt, int N, int K, int ksplit, bf16* Ob, int ldo, float* Of, const float* vec, float scale0, int scale_cols, unsigned* waitctr,
                                         int row_base = ML, int mtiles = 4, bool fromfront = false) {
    FRESH_IDS();
    const int fr = lane & 15, fq = lane >> 4, G = gridDim.x, bx = blockIdx.x;
    const int ntn = (N + 63) >> 6, ntiles = mtiles * ntn * ksplit, Kp = K / ksplit;
    const int tfirst = fromfront ? bx : G - 1 - bx;
    bf16* As = (bf16*)lds; bf16* Bs = (bf16*)(lds + 67584);
    if (waitctr != nullptr && tfirst < ntiles) ctx_wait(waitctr);
    for (int t = tfirst; t < ntiles; t += G) {
        const int ks = t % ksplit, r = t / ksplit, mt = r % mtiles, ntl = r / mtiles;
        const int n0 = ntl * 64, k0 = ks * Kp;
        const int m0 = mt * 128 + wave * 16;
        const bf16* ag = A + (size_t)(mt * 128 + (tid >> 5)) * K + k0 + 8 * (tid & 31);
        const bf16* bg = Bt + (size_t)(n0 + (tid >> 5)) * K + k0 + 8 * (tid & 31);
        f32x4 acc[4];
#pragma unroll
        for (int nt = 0; nt < 4; ++nt) acc[nt] = (f32x4){0.f, 0.f, 0.f, 0.f};
        v4u ra[8], rb[4];
#pragma unroll
        for (int i = 0; i < 8; ++i) ra[i] = *(const v4u*)(ag + (size_t)i * 16 * K);
#pragma unroll
        for (int i = 0; i < 4; ++i) rb[i] = *(const v4u*)(bg + (size_t)i * 16 * K);
        for (int kk = 0; kk < Kp; kk += 256) {
            __syncthreads();
#pragma unroll
            for (int i = 0; i < 8; ++i) *(v4u*)(As + ((tid >> 5) + 16 * i) * 264 + 8 * (tid & 31)) = ra[i];
#pragma unroll
            for (int i = 0; i < 4; ++i) *(v4u*)(Bs + ((tid >> 5) + 16 * i) * 264 + 8 * (tid & 31)) = rb[i];
            __syncthreads();
            if (kk + 256 < Kp) {
#pragma unroll
                for (int i = 0; i < 8; ++i) ra[i] = *(const v4u*)(ag + (size_t)i * 16 * K + kk + 256);
#pragma unroll
                for (int i = 0; i < 4; ++i) rb[i] = *(const v4u*)(bg + (size_t)i * 16 * K + kk + 256);
            }
#pragma unroll
            for (int j = 0; j < 8; ++j) { const bf16x8 a = *(const bf16x8*)(As + (wave * 16 + fr) * 264 + 32 * j + 8 * fq);
#pragma unroll
                for (int nt = 0; nt < 4; ++nt) { const bf16x8 b = *(const bf16x8*)(Bs + (16 * nt + fr) * 264 + 32 * j + 8 * fq); acc[nt] = MFMA16(b, a, acc[nt]); } }
        }
        const int row = m0 + fr;
#pragma unroll
        for (int nt = 0; nt < 4; ++nt) { const int col = n0 + 16 * nt + 4 * fq; f32x4 v = acc[nt];
            if (MODE == 0) { if (col < scale_cols) v = v * scale0; v2u w; w.x = pk2(v[0], v[1]); w.y = pk2(v[2], v[3]); *(v2u*)(Ob + (size_t)(row_base + row) * ldo + col) = w; }
            else if (MODE == 1) {
#pragma unroll
                for (int e = 0; e < 4; ++e) { const float a = fmaxf(v[e], 0.f); v[e] = a * a; }
                v2u w; w.x = pk2(v[0], v[1]); w.y = pk2(v[2], v[3]); *(v2u*)(Ob + (size_t)(row_base + row) * ldo + col) = w; }
            else if (MODE == 2) {
                if (col < 3072) { v2u w; w.x = pk2(v[0], v[1]); w.y = pk2(v[2], v[3]); *(v2u*)(Ob + (size_t)(row_base + row) * 3072 + col) = w; }
                else if (col < 3104) { *(f32x4*)(Of + (size_t)(row_base + row) * 32 + (col - 3072)) = v + *(const f32x4*)(vec + (col - 3072)); } }
            else if (MODE == 4) { if (col < 32) *(f32x4*)(Of + (size_t)(row_base + row) * 32 + col) = v + *(const f32x4*)(vec + col); }
            else { const f32x4 g = *(const f32x4*)(vec + col); *(f32x4*)(Of + ((size_t)ks * 512 + row) * 1024 + col) = g * v; }
        }
    }
}

#define XB_TMO      128
#define XB_XCNT(j)  (256  + 64 * (j))
#define XB_XSUB(j)  (1280 + 64 * (j))
#define XB_XGEN(j)  (2304 + 64 * (j))
#define XB_TOP      3328
#define XB_TOPGEN   3392
#define XCD_BAR_WORDS 3456
#define XB_SPIN_CAP (1u << 18)

__device__ __forceinline__ unsigned xb_ld(unsigned* p)              { return __hip_atomic_load(p, __ATOMIC_RELAXED, __HIP_MEMORY_SCOPE_AGENT); }
__device__ __forceinline__ unsigned xb_add(unsigned* p, unsigned v) { return __hip_atomic_fetch_add(p, v, __ATOMIC_RELAXED, __HIP_MEMORY_SCOPE_AGENT); }
__device__ __forceinline__ unsigned xb_xcc_id() { return (unsigned)__builtin_amdgcn_s_getreg((3 << 11) | 20) & 0xFu; }
#define XB_SPIN(cond, bar) do { unsigned _sp = 0; while (cond) { __builtin_amdgcn_s_sleep(1); \
    if ((++_sp & 255u) == 0u) { if (xb_ld(&(bar)[XB_TMO])) break; if (_sp > XB_SPIN_CAP) { atomicAdd(&(bar)[XB_TMO], 1u); break; } } } } while (0)

struct XcdBarrier {
    unsigned* bar; unsigned x;
    volatile LAS unsigned* st;
};

__device__ __forceinline__ XcdBarrier xcd_barrier_post(unsigned* bar, volatile LAS unsigned* st) {
    XcdBarrier b; b.bar = bar; b.x = xb_xcc_id(); b.st = st;
    if (threadIdx.x == 0) (void)xb_add(&bar[XB_XCNT(b.x)], 1u);
    return b;
}
__device__ __forceinline__ void xcd_barrier_complete(unsigned* bar, unsigned x, unsigned& nloc, unsigned& nx) {
    const unsigned G = gridDim.x * gridDim.y * gridDim.z;
    unsigned sum, cnt, mine, sp = 0u;
    for (;;) {
        sum = 0u; cnt = 0u; mine = 0u;
#pragma unroll
        for (unsigned j = 0; j < 16; ++j) { const unsigned c = xb_ld(&bar[XB_XCNT(j)]); sum += c; cnt += (c > 0u) ? 1u : 0u; mine = (j == x) ? c : mine; }
        if (sum == G) break;
        __builtin_amdgcn_s_sleep(1);
        if ((++sp & 255u) == 0u) { if (xb_ld(&bar[XB_TMO])) break; if (sp > XB_SPIN_CAP) { atomicAdd(&bar[XB_TMO], 1u); break; } }
    }
    nloc = mine > 0u ? mine : 1u; nx = cnt > 0u ? cnt : 1u;
}

__device__ __forceinline__ void xcd_barrier(const XcdBarrier& b) {
    asm volatile("s_waitcnt vmcnt(0)" ::: "memory");
    __syncthreads();
    if (threadIdx.x == 0) {
        unsigned* bar = b.bar;
        __builtin_amdgcn_s_waitcnt(0);
        unsigned nloc = b.st[0], nx = b.st[1];
        if (nloc == 0u) { xcd_barrier_complete(bar, b.x, nloc, nx); b.st[0] = nloc; b.st[1] = nx; }
        const unsigned old = xb_add(&bar[XB_XSUB(b.x)], 1u);
        const unsigned gen = old / nloc;
        if (old + 1u == (gen + 1u) * nloc) {
            __builtin_amdgcn_fence(__ATOMIC_RELEASE, "agent");
            asm volatile("s_waitcnt vmcnt(0)" ::: "memory");
            const unsigned og = xb_add(&bar[XB_TOP], 1u);
            const unsigned tg = og / nx;
            if (og + 1u == (tg + 1u) * nx) xb_add(&bar[XB_TOPGEN], 1u);
            else XB_SPIN(xb_ld(&bar[XB_TOPGEN]) == tg, bar);
            __builtin_amdgcn_fence(__ATOMIC_ACQUIRE, "agent");
            xb_add(&bar[XB_XGEN(b.x)], 1u);
            asm volatile("s_waitcnt vmcnt(0)" ::: "memory");
        } else {
            XB_SPIN(xb_ld(&bar[XB_XGEN(b.x)]) == gen, bar);
            __builtin_amdgcn_fence(__ATOMIC_ACQUIRE, "agent");
            asm volatile("s_waitcnt vmcnt(0)" ::: "memory");
        }
    }
    __syncthreads();
}

#ifndef XP_MIX
#define XP_MIX 0
#endif
#ifndef XP_CTX
#define XP_CTX 0
#endif
#ifndef XP_P5
#define XP_P5 0
#endif
#ifndef XP_NORM
#define XP_NORM 0
#endif
#ifndef XP_PRO
#define XP_PRO 0
#endif
#ifndef XP_GST
#define XP_GST 0
#endif
__global__ void __launch_bounds__(NTHR, 2) fwd_megakernel(Params pk) {
    extern __shared__ __attribute__((aligned(16))) unsigned char lds[];
    if (threadIdx.x == 0) *(Params*)(lds + PARAM_OFF) = pk;
    if (threadIdx.x < 16) ((unsigned*)(lds + 131072))[threadIdx.x] = 0u;
    __syncthreads();
    (void)xcd_barrier_post((unsigned*)(pk.ws + WS_BAR), (volatile LAS unsigned*)((LAS unsigned char*)lds + 131072));
#pragma unroll 1
    for (int ph = 0; ph < 37; ++ph) {
        if (ph > 0) { const int l_ = (ph - 1) / 9, st_ = (ph - 1) % 9;
            if (((st_ == 3 || st_ == 4) && (l_ % 3) != 0) || st_ == 6 || (st_ == 0 && l_ > 0)) continue; }
        asm volatile("" ::: "memory");
        Params p;
        { const unsigned* src = (const unsigned*)(lds + PARAM_OFF); unsigned* dstw = (unsigned*)&p;
#pragma unroll
          for (int i = 0; i < (int)(sizeof(Params) / 4); ++i) dstw[i] = (unsigned)__builtin_amdgcn_readfirstlane((int)src[i]); }
#define GP(f) do { __attribute__((address_space(1))) char* g_ = (__attribute__((address_space(1))) char*)(char*)(p.f); asm volatile("" : "+s"(g_)); p.f = (decltype(p.f))(char*)g_; } while (0)
        GP(x); GP(c); GP(ctx); GP(c_ctx); GP(ada_w); GP(ada_b); GP(norm_g); GP(final_g); GP(mlp_w1); GP(mlp_w2); GP(a_w_in); GP(a_w_gate); GP(a_b_gate); GP(a_head_g); GP(a_w_out);
        GP(b_w_qkv); GP(b_sinks); GP(b_w_out); GP(c_w_in); GP(c_conv_w); GP(c_conv_b); GP(c_w_out); GP(out); GP(ws);
#undef GP
        unsigned char* ws = p.ws;
        const int G = gridDim.x, bx = blockIdx.x;
        LAS unsigned char* ldsl = (LAS unsigned char*)lds;
        if (ph == 0) { phase_prologue(p, lds); }
        else {
            const int l = (ph - 1) / 9, step = (ph - 1) % 9, kind = l % 3, jx = l / 3;
            const bool ctx_out = l != 3;
            const float* ml = (const float*)(ws + WS_MOD) + (size_t)l * 3 * 6144;
            bf16* XN = (bf16*)(ws + WS_XN); bf16* HG = (bf16*)(ws + WS_HG); bf16* ACT = (bf16*)(ws + WS_ACT);
            unsigned* cctr = (unsigned*)(ws + WS_XCNT) + 8 * 64 * 64;
            if (step == 0) { phase_norm(p, p.x, MT, p.norm_g, ml + 0 * 1024, ml + 1 * 1024, 0); }
            else if (step == 1) {
                const bf16* XNC = XN + (size_t)ML * D;
                unsigned* wc_ = l > 0 ? cctr + 64 * (2 * l) : nullptr;
                if (l > 0) ctx_norm_part(p, p.norm_g + (size_t)(l * 2 + 0) * D, ml + 0 * 1024, ml + 1 * 1024, 4, wc_);
                if (kind == 0) { const bf16* W = (const bf16*)(ws + WS_AIN) + (size_t)jx * 3328 * D;
                    { pg8::Gemm g{XN, W, ML, 3072, D}; pg8::StaticOrder S; S.init(ML, 3072, G, bx);
                      pg8::EpiStore<0> E{ACT, 3072};
                      pg8::gemm_phase<pg8::EpiStore<0>, pg8::StaticOrder, true, true>(ldsl, g, S, E); }
                    ctx_gemm<0>(lds, XNC, W, 3072, D, 1, ACT, 3072, nullptr, nullptr, 1.f, 0, wc_);
                    ctx_gemm<4>(lds, XN, W + (size_t)3072 * D, 32, D, 1, nullptr, 0, (float*)(ws + WS_G), p.a_b_gate + jx * 32, 1.f, 0, wc_, 0, MT / 128, true); }
                else if (kind == 1) { const bf16* W = (const bf16*)(ws + WS_BQKV);
                    { pg8::Gemm g{XN, W, ML, 1536, D}; pg8::StaticOrder S; S.init(ML, 1536, G, bx);
                      pg8::EpiQkvRope E{ACT, (const float*)(ws + WS_ROPE), (const float*)(ws + WS_ROPE) + 2048};
                      pg8::gemm_phase<pg8::EpiQkvRope, pg8::StaticOrder, true, true>(ldsl, g, S, E); }
                    ctx_gemm<0>(lds, XNC, W, 1536, D, 1, ACT, 1536, nullptr, nullptr, 0.18033688011112042f, 1024, wc_); }
                else { const bf16* W = (const bf16*)(ws + WS_CIN);
                    { pg8::Gemm g{XN, W, ML, 3072, D}; pg8::StaticOrder S; S.init(ML, 3072, G, bx);
                      pg8::EpiStore<0> E{ACT, 3072};
                      pg8::gemm_phase<pg8::EpiStore<0>, pg8::StaticOrder, true, true>(ldsl, g, S, E); }
                    ctx_gemm<0>(lds, XNC, W, 3072, D, 1, ACT, 3072, nullptr, nullptr, 1.f, 0, wc_); }
            }
            else if (step == 2) {
                if (kind == 0) phase_mlstm_local(p, lds); else if (kind == 1) phase_attn(p, lds, ctx_out); else phase_conv(p, MT); }
            else if (step == 3) { phase_mlstm_scan(p); }
            else if (step == 4) { phase_mlstm_out(p, lds, jx, ctx_out); }
            else if (step == 5 || step == 8) {
                const bool dn = step == 8;
                const bf16* wout = kind == 0 ? (const bf16*)(ws + WS_AOUT) + (size_t)jx * D * D : (kind == 1 ? (const bf16*)(ws + WS_BOUT) : (const bf16*)(ws + WS_COUT));
                const bf16* Aop = dn ? ACT : HG; const bf16* W = dn ? (const bf16*)(ws + WS_W2) + (size_t)l * D * FF : wout; const int Kd = dn ? FF : D;
                const int fin = (dn && l == 3) ? 1 : 0, fi = 2 * l + (dn ? 1 : 0);
                const float* mn = dn ? ml + 3 * 6144 : ml;
                const float* ng = fin ? p.final_g : p.norm_g + (size_t)(dn ? (l + 1) * 2 : l * 2 + 1) * D;
                const float* nsh = fin ? ml : mn + (dn ? 0 : 3) * 1024; const float* nsc = fin ? ml : mn + (dn ? 1 : 4) * 1024;
                { pg8::Gemm g{Aop, W, ML, D, Kd}; pg8::StaticOrder S; S.init(ML, D, G, bx);
                  pg8::EpiResidNorm E{p.out, (l == 0 && !dn) ? p.x : p.out, XN, ml + (dn ? 5 : 2) * 1024, ng, nsh, nsc, (unsigned*)(ws + WS_XSLOT) + (size_t)fi * ML * 4, (unsigned*)(ws + WS_XCNT) + fi * 64 * 64, fin};
                  pg8::gemm_phase<pg8::EpiResidNorm, pg8::StaticOrder, false, true>(ldsl, g, S, E); }
                if (ctx_out) ctx_gemm<3>(lds, Aop + (size_t)ML * Kd, W, D, Kd, 4, nullptr, 0, (float*)(ws + WS_PART), ml + 2 * 6144 + (dn ? 5 : 2) * 1024, 1.f, 0, nullptr);
            }
            else { const bf16* W = (const bf16*)(ws + WS_W1) + (size_t)l * D * FF;
                unsigned* wc_ = cctr + 64 * (2 * l + 1);
                if (ctx_out) ctx_norm_part(p, p.norm_g + (size_t)(l * 2 + 1) * D, ml + 3 * 1024, ml + 4 * 1024, 4, wc_);
                { pg8::Gemm g{XN, W, ML, FF, D}; pg8::StaticOrder S; S.init(ML, FF, G, bx);
                  pg8::EpiStore<1> E{ACT, FF};
                  pg8::gemm_phase<pg8::EpiStore<1>, pg8::StaticOrder, true, true>(ldsl, g, S, E); }
                if (ctx_out) ctx_gemm<1>(lds, XN + (size_t)ML * D, W, FF, D, 1, ACT, FF, nullptr, nullptr, 1.f, 0, wc_); }
        }
        if (ph == 36) break;
        { XcdBarrier xb; xb.bar = (unsigned*)(ws + WS_BAR); xb.x = xb_xcc_id(); xb.st = (volatile LAS unsigned*)(ldsl + 131072); xcd_barrier(xb); }
    }
}

extern "C" void kernel_launch(void* const* d_in, const int* in_sizes, int n_in, void* d_out, int out_size, void* d_ws, size_t ws_size, hipStream_t stream) {
    static int grid = 0;
    if (grid == 0) {
        if (n_in != 22 || ws_size < WS_END) { fprintf(stderr, "kernel_launch: unexpected n_in %d / ws_size %zu (need %zu)\n", n_in, ws_size, (size_t)WS_END); grid = -1; return; }
        int dev = 0, cus = 0, per_cu = 0;
        hipGetDevice(&dev); hipDeviceGetAttribute(&cus, hipDeviceAttributeMultiprocessorCount, dev);
        if (hipFuncSetAttribute((const void*)fwd_megakernel, hipFuncAttributeMaxDynamicSharedMemorySize, LDS_BYTES) != hipSuccess) { fprintf(stderr, "kernel_launch: hipFuncSetAttribute failed\n"); grid = -1; return; }
        if (hipOccupancyMaxActiveBlocksPerMultiprocessor(&per_cu, (const void*)fwd_megakernel, NTHR, LDS_BYTES) != hipSuccess || per_cu < 1) { fprintf(stderr, "kernel_launch: occupancy query reports %d\n", per_cu); per_cu = 1; }
        (void)hipGetLastError();
        if (cus != 256) { fprintf(stderr, "kernel_launch: built for a 256-CU device (one 256x256 unit per workgroup in the fused residual+norm GEMM phases); found %d\n", cus); grid = -1; return; }
        grid = cus * 1;
    }
    if (grid < 0) return;
    if (hipMemsetAsync((char*)d_ws + WS_XCNT, 0, ZERO_BYTES, stream) != hipSuccess) { fprintf(stderr, "kernel_launch: memset failed\n"); return; }
    Params p{};
    const float** pp = (const float**)&p;
    for (int i = 0; i < 22; ++i) pp[i] = (const float*)d_in[i];
    p.out = (float*)d_out; p.ws = (unsigned char*)d_ws;
    void* args[] = {&p};
    hipError_t e = hipLaunchCooperativeKernel((const void*)fwd_megakernel, dim3(grid), dim3(NTHR), args, LDS_BYTES, stream);
    if (e != hipSuccess) fprintf(stderr, "cooperative launch failed: %s (grid %d)\n", hipGetErrorString(e), grid);
}
```

```cpp
#include <hip/hip_runtime.h>
#include <hip/hip_cooperative_groups.h>
#include <cstdio>
#include <cstdint>
namespace cg = cooperative_groups;

namespace pg8 {
#define PG8_LAS __attribute__((address_space(3)))
typedef unsigned short bf16_t;
typedef short bf16x8 __attribute__((ext_vector_type(8)));
typedef float f32x4 __attribute__((ext_vector_type(4)));
typedef unsigned u32x4 __attribute__((ext_vector_type(4)));
constexpr int BM = 256, BK = 64, HALF = 128, HTB = HALF * BK * 2  , STAGE_BYTES = 8 * HTB, NXCD = 8, WGM = 8;

__host__ __device__ __forceinline__ int lds_byte(int r, int c) { const int st = (r >> 4) * 2 + (c >> 5), rr = r & 15, cc = c & 31, ob = rr * 64 + cc * 2; return st * 1024 + (ob ^ (((ob >> 9) & 1) << 5)); }
__host__ __device__ __forceinline__ void stage_rc(int b, int& R, int& C) { const int st = b / 1024, sb = b % 1024, swz = sb ^ (((sb >> 9) & 1) << 5); R = (st >> 1) * 16 + swz / 64; C = (st & 1) * 32 + (swz % 64) / 2; }
__host__ __device__ __forceinline__ int perm32(int rho) { const int n = rho >> 4, i = rho & 15; return 8 * (i >> 2) + 4 * n + (i & 3); }

struct Unit { int pm, pn; };
struct Gemm { const bf16_t* A; const bf16_t* Bt; int M, N, K; };

struct StaticOrder {
    int nM, nN, nwg, G, c;
    __host__ __device__ void init(int M, int N, int G_, int c_) { nM = M / BM; nN = N / BM; nwg = nM * nN; G = G_; c = c_; }
    __host__ __device__ bool next(int i, Unit& u) const {
        const long L = (long)i * G + c; if (L >= nwg) return false;
        int wgid = (int)L; { const int q = nwg / NXCD, r = nwg % NXCD, xcd = wgid % NXCD, off = wgid / NXCD; wgid = (xcd < r ? xcd * (q + 1) : r * (q + 1) + (xcd - r) * q) + off; }
        const int nig = WGM * nN, gid = wgid / nig, fm = gid * WGM, gsz = (nM - fm) < WGM ? (nM - fm) : WGM;
        u.pm = fm + ((wgid % nig) % gsz); u.pn = (wgid % nig) / gsz; return true;
    }
    __device__ __forceinline__ void a_ready(const Unit&) const {}
    __device__ __forceinline__ void done(const Unit&) const {}
};

__device__ __forceinline__ unsigned cvt_pk_bf16(float lo, float hi) { unsigned r; asm volatile("v_cvt_pk_bf16_f32 %0, %1, %2" : "=v"(r) : "v"(lo), "v"(hi)); return r; }
typedef float f32x2 __attribute__((ext_vector_type(2)));
typedef unsigned u32x2 __attribute__((ext_vector_type(2)));
constexpr int ROWS_LAT = 16384;

template <int ACT> struct EpiStore {
    static constexpr bool PERM = true, AFTER_DRAIN = false;
    bf16_t* O; int ldc;
    __device__ __forceinline__ void operator()(const f32x4 (&acc)[2][2][4][2], const Unit& u, int wr, int wc, int fr, int fq) const {
        const int row0 = u.pm * BM + wr * 64 + fr, col0 = u.pn * BM + wc * 32 + 8 * fq;
#pragma unroll
        for (int ai = 0; ai < 2; ++ai)
#pragma unroll
            for (int m = 0; m < 4; ++m) { bf16_t* rowp = O + (size_t)(row0 + ai * HALF + m * 16) * ldc + col0;
#pragma unroll
                for (int bj = 0; bj < 2; ++bj) { f32x4 v0 = acc[ai][bj][m][0], v1 = acc[ai][bj][m][1];
                    if (ACT == 1) {
#pragma unroll
                        for (int e = 0; e < 4; ++e) { float a = fmaxf(v0[e], 0.f), b = fmaxf(v1[e], 0.f); v0[e] = a * a; v1[e] = b * b; } }
                    u32x4 w; w.x = cvt_pk_bf16(v0[0], v0[1]); w.y = cvt_pk_bf16(v0[2], v0[3]); w.z = cvt_pk_bf16(v1[0], v1[1]); w.w = cvt_pk_bf16(v1[2], v1[3]);
                    *(u32x4*)(rowp + bj * HALF) = w; } }
    }
};
struct EpiAIn {
    static constexpr bool PERM = true, AFTER_DRAIN = false;
    bf16_t* O; float* G; const float* bg;
    __device__ __forceinline__ void operator()(const f32x4 (&acc)[2][2][4][2], const Unit& u, int wr, int wc, int fr, int fq) const {
        const int row0 = u.pm * BM + wr * 64 + fr;
        if (u.pn < 12) {
            const int col0 = u.pn * BM + wc * 32 + 8 * fq;
#pragma unroll
            for (int ai = 0; ai < 2; ++ai)
#pragma unroll
                for (int m = 0; m < 4; ++m) { bf16_t* rowp = O + (size_t)(row0 + ai * HALF + m * 16) * 3072 + col0;
#pragma unroll
                    for (int bj = 0; bj < 2; ++bj) { const f32x4 v0 = acc[ai][bj][m][0], v1 = acc[ai][bj][m][1];
                        u32x4 w; w.x = cvt_pk_bf16(v0[0], v0[1]); w.y = cvt_pk_bf16(v0[2], v0[3]); w.z = cvt_pk_bf16(v1[0], v1[1]); w.w = cvt_pk_bf16(v1[2], v1[3]);
                        *(u32x4*)(rowp + bj * HALF) = w; } }
        } else if (wc == 0) {
            const f32x4 b0 = *(const f32x4*)(bg + 8 * fq), b1 = *(const f32x4*)(bg + 8 * fq + 4);
#pragma unroll
            for (int ai = 0; ai < 2; ++ai)
#pragma unroll
                for (int m = 0; m < 4; ++m) { float* gp = G + (size_t)(row0 + ai * HALF + m * 16) * 32 + 8 * fq;
                    *(f32x4*)gp = acc[ai][0][m][0] + b0; *(f32x4*)(gp + 4) = acc[ai][0][m][1] + b1; }
        }
    }
};
struct EpiQkvRope {
    static constexpr bool PERM = false, AFTER_DRAIN = false;
    bf16_t* O; const float* ct; const float* st;
    __device__ __forceinline__ void operator()(const f32x4 (&acc)[2][2][4][2], const Unit& u, int wr, int wc, int fr, int fq) const {
        const int colb = u.pn * BM + wc * 32 + 4 * fq;
        const bool rope = (u.pm < 64) && (u.pn < 5);
        const float sc = (u.pn < 4) ? 0.18033688011112042f : 1.0f;
#pragma unroll
        for (int ai = 0; ai < 2; ++ai)
#pragma unroll
            for (int m = 0; m < 4; ++m) { const int row = u.pm * BM + ai * HALF + wr * 64 + m * 16 + fr;
                f32x4 c = (f32x4){1.f, 1.f, 1.f, 1.f}, s = (f32x4){0.f, 0.f, 0.f, 0.f};
                if (rope) { const int sq = row & 8191; const int pos = (wc & 1) ? (sq & 63) : (sq >> 6); c = *(const f32x4*)(ct + pos * 16 + 4 * fq); s = *(const f32x4*)(st + pos * 16 + 4 * fq); }
                bf16_t* rowp = O + (size_t)row * 1536 + colb;
#pragma unroll
                for (int bj = 0; bj < 2; ++bj) { const f32x4 x1 = acc[ai][bj][m][0], x2 = acc[ai][bj][m][1];
                    const f32x4 o1 = (x1 * c - x2 * s) * sc, o2 = (x2 * c + x1 * s) * sc;
                    u32x2 w1, w2; w1.x = cvt_pk_bf16(o1[0], o1[1]); w1.y = cvt_pk_bf16(o1[2], o1[3]); w2.x = cvt_pk_bf16(o2[0], o2[1]); w2.y = cvt_pk_bf16(o2[2], o2[3]);
                    *(u32x2*)(rowp + bj * HALF) = w1; *(u32x2*)(rowp + bj * HALF + 16) = w2; } }
    }
};
struct EpiResid {
    static constexpr bool PERM = false, AFTER_DRAIN = false;
    float* hl; float* hc; const float* gate;
    __device__ __forceinline__ void operator()(const f32x4 (&acc)[2][2][4][2], const Unit& u, int wr, int wc, int fr, int fq) const {
        const int r = (u.pm < 64) ? (u.pm >> 5) : 2;
        float* hb = (u.pm < 64) ? hl : (hc - (size_t)ROWS_LAT * 1024);
        const int col0 = u.pn * BM + wc * 32 + 4 * fq;
        const float* gp = gate + r * 6144 + col0;
        f32x4 gv[2][2];
#pragma unroll
        for (int bj = 0; bj < 2; ++bj)
#pragma unroll
            for (int n = 0; n < 2; ++n) gv[bj][n] = *(const f32x4*)(gp + bj * HALF + n * 16);
#pragma unroll
        for (int ai = 0; ai < 2; ++ai)
#pragma unroll
            for (int m = 0; m < 4; ++m) { float* p = hb + (size_t)(u.pm * BM + ai * HALF + wr * 64 + m * 16 + fr) * 1024 + col0;
#pragma unroll
                for (int bj = 0; bj < 2; ++bj)
#pragma unroll
                    for (int n = 0; n < 2; ++n) { f32x4 hv = *(const f32x4*)(p + bj * HALF + n * 16); hv = hv + gv[bj][n] * acc[ai][bj][m][n]; *(f32x4*)(p + bj * HALF + n * 16) = hv; }
                if (m & 1) asm volatile("" ::: "memory"); }
    }
};


__device__ __forceinline__ float shx_pg(float v, int o, int lane) { return __builtin_bit_cast(float, __builtin_amdgcn_ds_bpermute((lane ^ o) << 2, __builtin_bit_cast(int, v))); }
struct EpiResidNorm {
    static constexpr bool PERM = false, AFTER_DRAIN = true;
    float* h; const float* hsrc; bf16_t* xn; const float* gate; const float* g; const float* shift; const float* scale; unsigned* xslots; unsigned* cnt; int fin;
    __device__ __forceinline__ void operator()(const f32x4 (&)[2][2][4][2], const Unit&, int, int, int, int) const {}
    __device__ __forceinline__ void fused(f32x4 (&acc)[2][2][4][2], const Unit& u, int wr, int wc, int fr, int fq, PG8_LAS unsigned char* lds, int wid, int lane) const {
        const int r = u.pm >> 5, col0 = u.pn * BM + wc * 32 + 4 * fq;
        PG8_LAS float* Pl = (PG8_LAS float*)lds; PG8_LAS float* Sl = (PG8_LAS float*)(lds + 4096);
        {
            const float* gp = gate + r * 6144 + col0; f32x4 gv[2][2];
#pragma unroll
            for (int bj = 0; bj < 2; ++bj)
#pragma unroll
                for (int n = 0; n < 2; ++n) gv[bj][n] = *(const f32x4*)(gp + bj * HALF + n * 16);
#pragma unroll
            for (int ai = 0; ai < 2; ++ai)
#pragma unroll
                for (int m = 0; m < 4; ++m) { const float* p = hsrc + (size_t)(u.pm * BM + ai * HALF + wr * 64 + m * 16 + fr) * 1024 + col0;
#pragma unroll
                    for (int bj = 0; bj < 2; ++bj)
#pragma unroll
                        for (int n = 0; n < 2; ++n) { const f32x4 hv = *(const f32x4*)(p + bj * HALF + n * 16); acc[ai][bj][m][n] = hv + gv[bj][n] * acc[ai][bj][m][n]; }
                    asm volatile("" : "+v"(acc[ai][0][m][0]), "+v"(acc[ai][0][m][1]), "+v"(acc[ai][1][m][0]), "+v"(acc[ai][1][m][1]) :: "memory"); }
        }
#pragma unroll
        for (int ai = 0; ai < 2; ++ai)
#pragma unroll
            for (int m = 0; m < 4; ++m) { float s = 0.f;
#pragma unroll
                for (int bj = 0; bj < 2; ++bj)
#pragma unroll
                    for (int n = 0; n < 2; ++n) { const f32x4 x = acc[ai][bj][m][n]; s += (x[0] * x[0] + x[1] * x[1]) + (x[2] * x[2] + x[3] * x[3]); }
                s += shx_pg(s, 16, lane); s += shx_pg(s, 32, lane);
                if (fq == 0) Pl[(ai * HALF + wr * 64 + m * 16 + fr) * 4 + wc] = s; }
        asm volatile("s_waitcnt lgkmcnt(0)" ::: "memory"); __builtin_amdgcn_s_barrier(); asm volatile("" ::: "memory");
        const int tid = wid * 64 + lane;
        if (tid < 256) { const float tot = (Pl[tid * 4 + 0] + Pl[tid * 4 + 1]) + (Pl[tid * 4 + 2] + Pl[tid * 4 + 3]);
            __hip_atomic_store(xslots + ((size_t)(u.pm * BM + tid)) * 4 + u.pn, __builtin_bit_cast(unsigned, tot), __ATOMIC_RELAXED, __HIP_MEMORY_SCOPE_AGENT); }
        asm volatile("s_waitcnt vmcnt(0)" ::: "memory");
        if (wid < 4 && lane == 0) __hip_atomic_fetch_add(cnt + 64 * u.pm, 1u, __ATOMIC_RELAXED, __HIP_MEMORY_SCOPE_AGENT);
        if (wid == 0) { unsigned sp = 0;
            while ((unsigned)__builtin_amdgcn_readfirstlane((int)__hip_atomic_load(cnt + 64 * u.pm, __ATOMIC_RELAXED, __HIP_MEMORY_SCOPE_AGENT)) < 16u) { __builtin_amdgcn_s_sleep(2); if (++sp > (1u << 22)) break; }
            __builtin_amdgcn_fence(__ATOMIC_ACQUIRE, "agent"); }
        asm volatile("s_waitcnt vmcnt(0) lgkmcnt(0)" ::: "memory"); __builtin_amdgcn_s_barrier(); asm volatile("" ::: "memory");
        if (tid < 256) { const unsigned* sl = xslots + ((size_t)(u.pm * BM + tid)) * 4; float q = 0.f;
#pragma unroll
            for (int t = 0; t < 4; ++t) q += __builtin_bit_cast(float, __hip_atomic_load(sl + t, __ATOMIC_RELAXED, __HIP_MEMORY_SCOPE_AGENT));
            Sl[tid] = __builtin_amdgcn_rsqf(q * (1.0f / 1024.0f) + 1e-6f); }
        asm volatile("s_waitcnt lgkmcnt(0)" ::: "memory"); __builtin_amdgcn_s_barrier(); asm volatile("" ::: "memory");
        f32x4 gm[2][2], sh[2][2];
#pragma unroll
        for (int bj = 0; bj < 2; ++bj)
#pragma unroll
            for (int n = 0; n < 2; ++n) { const int c = col0 + bj * HALF + n * 16; const f32x4 gg = *(const f32x4*)(g + c);
                if (fin) { gm[bj][n] = gg; sh[bj][n] = (f32x4){0.f, 0.f, 0.f, 0.f}; }
                else { gm[bj][n] = gg * (*(const f32x4*)(scale + r * 6144 + c) + 1.0f); sh[bj][n] = *(const f32x4*)(shift + r * 6144 + c); } }
#pragma unroll
        for (int ai = 0; ai < 2; ++ai)
#pragma unroll
            for (int m = 0; m < 4; ++m) { const int rl = ai * HALF + wr * 64 + m * 16 + fr; const float rs = Sl[rl]; const size_t off = (size_t)(u.pm * BM + rl) * 1024 + col0;
#pragma unroll
                for (int bj = 0; bj < 2; ++bj)
#pragma unroll
                    for (int n = 0; n < 2; ++n) { const f32x4 x = acc[ai][bj][m][n];
                        if (fin) { *(f32x4*)(h + off + bj * HALF + n * 16) = (x * rs) * gm[bj][n]; }
                        else { *(f32x4*)(h + off + bj * HALF + n * 16) = x; const f32x4 y = (x * rs) * gm[bj][n] + sh[bj][n];
                            u32x2 w; w.x = cvt_pk_bf16(y[0], y[1]); w.y = cvt_pk_bf16(y[2], y[3]); *(u32x2*)(xn + off + bj * HALF + n * 16) = w; } }
                asm volatile("" ::: "memory"); }
    }
};

template <class Epi, class Sched, bool ALIGN_EPI = false, bool SP2 = false>
__device__ __forceinline__ void gemm_phase(PG8_LAS unsigned char* lds, const Gemm g, const Sched& S, const Epi& E) {
    int tid_ = threadIdx.x; asm volatile("" : "+v"(tid_)); const int tid = tid_, wid = __builtin_amdgcn_readfirstlane(tid >> 6), lane = tid & 63, wr = wid >> 2, wc = wid & 3, fr = lane & 15, fq = lane >> 4;
    const int K = g.K, nt = K / BK;
    unsigned voffA[2], voffB[2];
#pragma unroll
    for (int i = 0; i < 2; ++i) { int R, C; stage_rc(tid * 16 + i * 8192, R, C); const int Rb = Epi::PERM ? ((R & ~31) + perm32(R & 31)) : R;
        voffA[i] = (unsigned)(R * K + C) * 2u; voffB[i] = (unsigned)(Rb * K + C) * 2u; }
    const size_t kstep = (size_t)(BK * 2);
    const size_t hstep = (size_t)HALF * K * 2;
    const size_t tstep = 2 * hstep;
    const unsigned ldsw = (unsigned)wid * 1024u;
    const int aoff = lds_byte(wr * 64 + fr, fq * 8), boff = lds_byte(wc * 32 + fr, fq * 8);
#define PG8_SA(b, h) (((b) * 2 + (h)) * HTB)
#define PG8_SB(b, h) ((4 + (b) * 2 + (h)) * HTB)
#define PG8_STAGE(bufoff, gbase, voff) do { _Pragma("unroll") for (int _i = 0; _i < 2; ++_i) \
        __builtin_amdgcn_global_load_lds((const unsigned*)((const char*)(gbase) + (voff)[_i]), (PG8_LAS unsigned*)(lds + (bufoff) + ldsw + _i * 8192), 16, 0, 0); } while (0)
#define PG8_LDA(dst, b, h) do { _Pragma("unroll") for (int m = 0; m < 4; ++m) _Pragma("unroll") for (int k = 0; k < 2; ++k) dst[m][k] = *(const PG8_LAS bf16x8*)(lds + PG8_SA(b, h) + aoff + m * 2048 + k * 1024); } while (0)
#define PG8_LDB(dst, b, h) do { _Pragma("unroll") for (int n = 0; n < 2; ++n) _Pragma("unroll") for (int k = 0; k < 2; ++k) dst[n][k] = *(const PG8_LAS bf16x8*)(lds + PG8_SB(b, h) + boff + n * 2048 + k * 1024); } while (0)
#define PG8_MMA(ai, bj, At, Bt) do { __builtin_amdgcn_s_setprio(1); _Pragma("unroll") for (int m = 0; m < 4; ++m) _Pragma("unroll") for (int n = 0; n < 2; ++n) _Pragma("unroll") for (int k = 0; k < 2; ++k) \
        acc[ai][bj][m][n] = __builtin_amdgcn_mfma_f32_16x16x32_bf16(Bt[n][k], At[m][k], acc[ai][bj][m][n], 0, 0, 0); __builtin_amdgcn_s_setprio(0); } while (0)
#define PG8_WAIT_V(n) asm volatile("s_waitcnt vmcnt(" #n ")" ::: "memory")
#define PG8_WAIT_L(n) asm volatile("s_waitcnt lgkmcnt(" #n ")" ::: "memory")
#define PG8_BAR __builtin_amdgcn_s_barrier()
#define PG8_SCHED __builtin_amdgcn_sched_barrier(0)
    Unit cur, nxt; int ui = 0;
    if (!S.next(0, cur)) return;
    f32x4 acc[2][2][4][2];
#pragma unroll
    for (int a = 0; a < 2; ++a)
#pragma unroll
        for (int b = 0; b < 2; ++b)
#pragma unroll
            for (int m = 0; m < 4; ++m)
#pragma unroll
                for (int n = 0; n < 2; ++n) acc[a][b][m][n] = (f32x4){0.f, 0.f, 0.f, 0.f};
    bf16x8 At[4][2], B0[2][2], B1[2][2];
    const char* cA = (const char*)g.A + (size_t)cur.pm * tstep; const char* cB = (const char*)g.Bt + (size_t)cur.pn * tstep;
    S.a_ready(cur);
    if constexpr (SP2) {
        PG8_STAGE(PG8_SB(0, 0), cB, voffB); PG8_STAGE(PG8_SB(0, 1), cB + hstep, voffB); PG8_STAGE(PG8_SA(0, 0), cA, voffA); PG8_STAGE(PG8_SA(0, 1), cA + hstep, voffA);
        if (wr == 1) PG8_BAR;
        PG8_WAIT_V(2); PG8_BAR;
        PG8_STAGE(PG8_SB(1, 0), cB + kstep, voffB); PG8_STAGE(PG8_SA(1, 0), cA + kstep, voffA); PG8_STAGE(PG8_SB(1, 1), cB + hstep + kstep, voffB);
        PG8_WAIT_V(6); PG8_BAR;
    } else {
        PG8_STAGE(PG8_SB(0, 0), cB, voffB); PG8_STAGE(PG8_SA(0, 0), cA, voffA); PG8_STAGE(PG8_SB(0, 1), cB + hstep, voffB); PG8_STAGE(PG8_SA(0, 1), cA + hstep, voffA);
        if (wr == 1) PG8_BAR;
        PG8_WAIT_V(4); PG8_BAR;
        PG8_STAGE(PG8_SB(1, 0), cB + kstep, voffB); PG8_STAGE(PG8_SA(1, 0), cA + kstep, voffA); PG8_STAGE(PG8_SB(1, 1), cB + hstep + kstep, voffB);
        PG8_WAIT_V(6); PG8_BAR;
    }
    for (;;) {
        const bool has_next = S.next(ui + 1, nxt);
        const char* nA = has_next ? (const char*)g.A + (size_t)nxt.pm * tstep : cA; const char* nB = has_next ? (const char*)g.Bt + (size_t)nxt.pn * tstep : cB;
        for (int t = 0; t < nt; t += 2) {
            const bool last = (t == nt - 2);
            const char* a1 = cA + (size_t)(t + 1) * kstep;
            const char* a2 = last ? nA : cA + (size_t)(t + 2) * kstep; const char* b2 = last ? nB : cB + (size_t)(t + 2) * kstep;
            const char* a3 = a2 + kstep; const char* b3 = b2 + kstep;
            if (last && has_next) S.a_ready(nxt);
            if constexpr (SP2) {
            PG8_LDB(B0, 0, 0); PG8_LDB(B1, 0, 1); PG8_SCHED; PG8_LDA(At, 0, 0); PG8_STAGE(PG8_SA(1, 1), a1 + hstep, voffA);
            PG8_WAIT_V(8); PG8_WAIT_L(0); PG8_BAR; PG8_MMA(0, 0, At, B0); PG8_MMA(0, 1, At, B1); PG8_BAR; PG8_SCHED;
            PG8_LDA(At, 0, 1); PG8_STAGE(PG8_SB(0, 0), b2, voffB); PG8_STAGE(PG8_SB(0, 1), b2 + hstep, voffB); PG8_STAGE(PG8_SA(0, 0), a2, voffA);
            PG8_WAIT_V(8); PG8_WAIT_L(0); PG8_BAR; PG8_MMA(1, 0, At, B0); PG8_MMA(1, 1, At, B1); PG8_BAR; PG8_SCHED;
            PG8_LDB(B0, 1, 0); PG8_LDB(B1, 1, 1); PG8_SCHED; PG8_LDA(At, 1, 0); PG8_STAGE(PG8_SA(0, 1), a2 + hstep, voffA);
            PG8_WAIT_V(8); PG8_WAIT_L(0); PG8_BAR; PG8_MMA(0, 0, At, B0); PG8_MMA(0, 1, At, B1); PG8_BAR; PG8_SCHED;
            PG8_LDA(At, 1, 1); PG8_STAGE(PG8_SB(1, 0), b3, voffB); PG8_STAGE(PG8_SB(1, 1), b3 + hstep, voffB); PG8_STAGE(PG8_SA(1, 0), a3, voffA);
            PG8_WAIT_V(8); PG8_WAIT_L(0); PG8_BAR; PG8_MMA(1, 0, At, B0); PG8_MMA(1, 1, At, B1); PG8_BAR; PG8_SCHED;
            } else {
            PG8_LDB(B0, 0, 0); PG8_SCHED; PG8_LDA(At, 0, 0); PG8_STAGE(PG8_SA(1, 1), a1 + hstep, voffA);
            PG8_WAIT_L(8); PG8_BAR; PG8_WAIT_L(0); PG8_MMA(0, 0, At, B0); PG8_BAR; PG8_SCHED;
            PG8_LDB(B1, 0, 1); PG8_STAGE(PG8_SB(0, 0), b2, voffB);
            PG8_BAR; PG8_WAIT_L(0); PG8_MMA(0, 1, At, B1); PG8_BAR;
            PG8_LDA(At, 0, 1); PG8_STAGE(PG8_SA(0, 0), a2, voffA);
            PG8_BAR; PG8_WAIT_L(0); PG8_MMA(1, 0, At, B0); PG8_BAR; PG8_SCHED;
            PG8_STAGE(PG8_SB(0, 1), b2 + hstep, voffB);
            PG8_WAIT_V(6); PG8_BAR; PG8_MMA(1, 1, At, B1); PG8_BAR;
            PG8_LDB(B0, 1, 0); PG8_SCHED; PG8_LDA(At, 1, 0); PG8_STAGE(PG8_SA(0, 1), a2 + hstep, voffA);
            PG8_WAIT_L(8); PG8_BAR; PG8_WAIT_L(0); PG8_MMA(0, 0, At, B0); PG8_BAR; PG8_SCHED;
            PG8_LDB(B1, 1, 1); PG8_STAGE(PG8_SB(1, 0), b3, voffB);
            PG8_BAR; PG8_WAIT_L(0); PG8_MMA(0, 1, At, B1); PG8_BAR;
            PG8_LDA(At, 1, 1); PG8_STAGE(PG8_SA(1, 0), a3, voffA);
            PG8_BAR; PG8_WAIT_L(0); PG8_MMA(1, 0, At, B0); PG8_BAR; PG8_SCHED;
            PG8_STAGE(PG8_SB(1, 1), b3 + hstep, voffB);
            PG8_WAIT_V(6); PG8_BAR; PG8_MMA(1, 1, At, B1); PG8_BAR;
            }
        }
        if constexpr (ALIGN_EPI) { if (wr == 0) PG8_BAR; }
        if constexpr (!Epi::AFTER_DRAIN) { E(acc, cur, wr, wc, fr, fq); S.done(cur); }
        if (!has_next) break;
#pragma unroll
        for (int a = 0; a < 2; ++a)
#pragma unroll
            for (int b = 0; b < 2; ++b)
#pragma unroll
                for (int m = 0; m < 4; ++m)
#pragma unroll
                    for (int n = 0; n < 2; ++n) acc[a][b][m][n] = (f32x4){0.f, 0.f, 0.f, 0.f};
        cur = nxt; cA = nA; cB = nB; ++ui;
        if constexpr (ALIGN_EPI) { if (wr == 1) PG8_BAR; }
    }
    PG8_WAIT_V(0);
    if constexpr (!ALIGN_EPI) { if (wr == 0) PG8_BAR; }
    PG8_BAR;
    if constexpr (Epi::AFTER_DRAIN) { E.fused(acc, cur, wr, wc, fr, fq, lds, wid, lane); S.done(cur); }
#undef PG8_SA
#undef PG8_SB
#undef PG8_STAGE
#undef PG8_LDA
#undef PG8_LDB
#undef PG8_MMA
#undef PG8_WAIT_V
#undef PG8_WAIT_L
#undef PG8_BAR
#undef PG8_SCHED
}
}

#define LAS __attribute__((address_space(3)))
typedef unsigned short bf16;
typedef float f32x4 __attribute__((ext_vector_type(4)));
typedef short bf16x8 __attribute__((ext_vector_type(8)));
typedef unsigned v4u __attribute__((ext_vector_type(4)));
typedef unsigned v2u __attribute__((ext_vector_type(2)));
constexpr int NWAVES = 8, NTHR = 512;
constexpr int D = 1024, SEQ = 8192, NBATCH = 2, CTXL = 256, FF = 4096;
constexpr int ML = NBATCH * SEQ, MT = ML + NBATCH * CTXL;
constexpr int NCH = 66;
constexpr int LDS_BYTES = 147456, PARAM_OFF = 131072 + 1024;
constexpr float NEG_BIG = -1.0e30f;

constexpr size_t MiB = 1u << 20;
constexpr size_t WS_MOD = 0;
constexpr size_t WS_ROPE = 512 * 1024;
constexpr size_t WS_MISC = 768 * 1024;
constexpr size_t WS_W1 = 1 * MiB;
constexpr size_t WS_W2 = WS_W1 + 32 * MiB;
constexpr size_t WS_AIN = WS_W2 + 32 * MiB;
constexpr size_t WS_AOUT = WS_AIN + 13 * MiB;
constexpr size_t WS_BQKV = WS_AOUT + 4 * MiB;
constexpr size_t WS_BOUT = WS_BQKV + 3 * MiB;
constexpr size_t WS_CIN = WS_BOUT + 2 * MiB;
constexpr size_t WS_COUT = WS_CIN + 6 * MiB;
constexpr size_t WS_HC = WS_COUT + 2 * MiB;
constexpr size_t WS_XN = WS_HC + 2 * MiB;
constexpr size_t WS_HG = WS_XN + 33 * MiB;
constexpr size_t WS_G = WS_HG + 33 * MiB;
constexpr size_t WS_DN = WS_G + 3 * MiB;
constexpr size_t WS_ACT = WS_DN + 1 * MiB;
constexpr size_t WS_DC = WS_XN;
constexpr size_t WS_CP = WS_ACT + 132 * MiB;
constexpr size_t WS_PART = WS_CP + 33 * MiB;
constexpr size_t WS_XCNT = WS_PART + 8 * MiB;
constexpr size_t XCNT_BYTES = 8 * 64 * 256 + 16 * 256;
constexpr size_t WS_BAR = WS_XCNT + 192 * 1024;
constexpr size_t ZERO_BYTES = 192 * 1024 + 16384;
constexpr size_t WS_XSLOT = WS_XCNT + 256 * 1024;
constexpr size_t WS_END = WS_XSLOT + 2 * MiB;

struct Params {
    const float *x, *c, *ctx, *c_ctx, *ada_w, *ada_b, *norm_g, *final_g, *mlp_w1, *mlp_w2;
    const float *a_w_in, *a_w_gate, *a_b_gate, *a_head_g, *a_w_out, *b_w_qkv, *b_sinks, *b_w_out, *c_w_in, *c_conv_w, *c_conv_b, *c_w_out;
    float* out; unsigned char* ws;
};

__device__ __forceinline__ unsigned f2bf(float f) { unsigned u = __builtin_bit_cast(unsigned, f); return (u + 0x7fffu + ((u >> 16) & 1u)) >> 16; }
typedef float f32x2_t __attribute__((ext_vector_type(2)));
typedef __bf16 bf16x2_t __attribute__((ext_vector_type(2)));
__device__ __forceinline__ unsigned pk2(float lo, float hi) { const f32x2_t v = {lo, hi}; const bf16x2_t b = __builtin_convertvector(v, bf16x2_t); return __builtin_bit_cast(unsigned, b); }
__device__ __forceinline__ float bf2f(unsigned short u) { return __builtin_bit_cast(float, (unsigned)u << 16); }
__device__ __forceinline__ float bflo(unsigned w) { return __builtin_bit_cast(float, w << 16); }
__device__ __forceinline__ float bfhi(unsigned w) { return __builtin_bit_cast(float, w & 0xffff0000u); }
__device__ __forceinline__ float shx(float v, int o, int lane) { return __builtin_bit_cast(float, __builtin_amdgcn_ds_bpermute((lane ^ o) << 2, __builtin_bit_cast(int, v))); }
__device__ __forceinline__ float shup(float v, int o, int lane) { const int src = lane >= o ? lane - o : lane; return __builtin_bit_cast(float, __builtin_amdgcn_ds_bpermute(src << 2, __builtin_bit_cast(int, v))); }
__device__ __forceinline__ float wave_sum(float v, int lane) {
#pragma unroll
    for (int o = 1; o < 64; o <<= 1) v += shx(v, o, lane);
    return v;
}
__device__ __forceinline__ float wave_max(float v, int lane) {
#pragma unroll
    for (int o = 1; o < 64; o <<= 1) v = fmaxf(v, shx(v, o, lane));
    return v;
}
__device__ __forceinline__ float logsig(float x) { return fminf(x, 0.f) - __logf(1.f + __expf(-fabsf(x))); }
__device__ __forceinline__ int chunk_row(int b, int j) { return j < 2 ? ML + b * 256 + j * 128 : b * SEQ + (j - 2) * 128; }
#define FRESH_IDS() int tid = threadIdx.x; asm volatile("" : "+v"(tid)); const int lane = tid & 63, wave = __builtin_amdgcn_readfirstlane(tid >> 6); (void)lane; (void)wave
#define MFMA16(a, b, c) __builtin_amdgcn_mfma_f32_16x16x32_bf16((a), (b), (c), 0, 0, 0)

__device__ __forceinline__ void p0_transpose_item(const float* W, int K, int N, bf16* WT, int row_off, LAS float* scr, int item, int lane) {
    const int nblk = N / 32, kb = item / nblk, nb = item % nblk, k0 = 64 * kb, n0 = 32 * nb;
#pragma unroll 8
    for (int i = 0; i < 32; ++i) { const int kk = 2 * i + (lane >> 5); scr[kk * 33 + (lane & 31)] = W[(size_t)(k0 + kk) * N + n0 + (lane & 31)]; }
    asm volatile("s_waitcnt lgkmcnt(0)" ::: "memory");
    const int c = lane & 7;
#pragma unroll
    for (int j = 0; j < 4; ++j) { const int n = (lane >> 3) + 8 * j; const LAS float* s = scr + (8 * c) * 33 + n;
        v4u o; o.x = pk2(s[0 * 33], s[1 * 33]); o.y = pk2(s[2 * 33], s[3 * 33]); o.z = pk2(s[4 * 33], s[5 * 33]); o.w = pk2(s[6 * 33], s[7 * 33]);
        *(v4u*)(WT + (size_t)(row_off + n0 + n) * K + k0 + 8 * c) = o; }
    asm volatile("s_waitcnt lgkmcnt(0)" ::: "memory");
}

__device__ __forceinline__ void p0_transpose64(const float* W, int K, int N, bf16* WT, LAS unsigned char* scr, int item, int lane) {
    const int nblk = N >> 6, kb = item / nblk, nb = item - kb * nblk, k0 = 64 * kb, n0 = 64 * nb;
    const int n4 = lane & 15, kq = lane >> 4;
    const float* src = W + (size_t)(k0 + 16 * kq) * N + n0 + 4 * n4;
    f32x4 v[16];
#pragma unroll
    for (int i = 0; i < 16; ++i) v[i] = *(const f32x4*)(src + (size_t)i * N);
#pragma unroll
    for (int e = 0; e < 4; ++e) { v4u lo, hi;
        lo.x = pk2(v[0][e], v[1][e]); lo.y = pk2(v[2][e], v[3][e]); lo.z = pk2(v[4][e], v[5][e]); lo.w = pk2(v[6][e], v[7][e]);
        hi.x = pk2(v[8][e], v[9][e]); hi.y = pk2(v[10][e], v[11][e]); hi.z = pk2(v[12][e], v[13][e]); hi.w = pk2(v[14][e], v[15][e]);
        LAS unsigned char* d = scr + (4 * n4 + e) * 144 + 32 * kq;
        *(LAS v4u*)d = lo; *(LAS v4u*)(d + 16) = hi; }
    asm volatile("s_waitcnt lgkmcnt(0)" ::: "memory");
#pragma unroll
    for (int j = 0; j < 8; ++j) { const int c = lane + 64 * j, n = c >> 3, kc = c & 7;
        const v4u o = *(const LAS v4u*)(scr + n * 144 + 16 * kc);
        *(v4u*)(WT + (size_t)(n0 + n) * K + k0 + 8 * kc) = o; }
    asm volatile("s_waitcnt lgkmcnt(0)" ::: "memory");
}

__device__ __forceinline__ void phase_prologue(const Params& p, unsigned char* lds) {
    FRESH_IDS();
    unsigned char* ws = p.ws;
    const int G = gridDim.x, bx = blockIdx.x;
    {
        float* sv = (float*)lds; float* red = (float*)(lds + 12288);
        for (int i = tid; i < 3072; i += NTHR) { const int r = i >> 10, k = i & 1023; const float xv = r < 2 ? p.c[r * 1024 + k] : p.c_ctx[k]; sv[i] = xv / (1.f + expf(-xv)); }
        __syncthreads();
        float* mod = (float*)(ws + WS_MOD);
        for (int item = bx; item < 384; item += G) {
            const int l = item / 96, col0 = (item % 96) * 64, tx = tid & 15, kg = tid >> 4;
            const float* W = p.ada_w + (size_t)l * 1024 * 6144 + col0 + tx * 4;
            f32x4 a0 = (f32x4){0.f, 0.f, 0.f, 0.f}, a1 = a0, a2 = a0;
#pragma unroll 8
            for (int kk = 0; kk < 32; ++kk) { const int k = kg * 32 + kk; const f32x4 w = *(const f32x4*)(W + (size_t)k * 6144); a0 += w * sv[k]; a1 += w * sv[1024 + k]; a2 += w * sv[2048 + k]; }
#pragma unroll
            for (int e = 0; e < 4; ++e) { red[(kg * 3 + 0) * 64 + tx * 4 + e] = a0[e]; red[(kg * 3 + 1) * 64 + tx * 4 + e] = a1[e]; red[(kg * 3 + 2) * 64 + tx * 4 + e] = a2[e]; }
            __syncthreads();
            if (tid < 192) { const int r = tid >> 6, ci = tid & 63; float s = 0.f;
                for (int g = 0; g < 32; ++g) s += red[(g * 3 + r) * 64 + ci];
                mod[(l * 3 + r) * 6144 + col0 + ci] = s + p.ada_b[l * 6144 + col0 + ci]; }
            __syncthreads();
        }
    }
    { int n0 = 0; for (int item = bx; item < 384; item += G) n0 += (item < 96) ? 1 : 0;
      asm volatile("s_waitcnt vmcnt(0)" ::: "memory"); __syncthreads();
      if (n0 > 0 && tid == 0) { __builtin_amdgcn_fence(__ATOMIC_RELEASE, "agent"); asm volatile("s_waitcnt vmcnt(0)" ::: "memory");
          __hip_atomic_fetch_add((unsigned*)(ws + WS_XCNT) + 8 * 64 * 64 + 64 * 15, (unsigned)n0, __ATOMIC_RELAXED, __HIP_MEMORY_SCOPE_AGENT); } }
    {
        const int gi = bx * NTHR + tid;
        if (gi < 2048) { const int pos = gi >> 4, i = gi & 15;
            const float invf = exp2f(-(float)i * (13.287712379549449f / 16.f));
            const float ang = (float)pos * invf;
            const double rev = (double)ang * 0.15915494309189535; const double fr = rev - rint(rev);
            float* ct = (float*)(ws + WS_ROPE); float* st = ct + 2048;
            ct[gi] = __builtin_amdgcn_cosf((float)fr); st[gi] = __builtin_amdgcn_sinf((float)fr); }
    }
    {
        const size_t gt = (size_t)bx * NTHR + tid, GT = (size_t)G * NTHR;
        const f32x4* cs = (const f32x4*)p.ctx; f32x4* cd = (f32x4*)(ws + WS_HC);
        for (size_t i = gt; i < (size_t)(MT - ML) * D / 4; i += GT) cd[i] = cs[i];
    }
    __syncthreads();
    {
        LAS unsigned char* scr = (LAS unsigned char*)lds + wave * 16384;
        const int gw = bx * NWAVES + wave, NGW = G * NWAVES;
        constexpr int I_UP = (D / 64) * (FF / 64), I_DN = (FF / 64) * (D / 64), I_AIN = (D / 64) * (3072 / 64), I_GATE = (D / 64), I_SQ = (D / 64) * (D / 64), I_BQ = (D / 64) * (1536 / 64);
        constexpr int NITEMS = 4 * I_UP + 4 * I_DN + 2 * I_AIN + 2 * I_GATE + 2 * I_SQ + I_BQ + I_SQ + I_AIN + I_SQ;
        for (int it = gw; it < NITEMS; it += NGW) {
            int r = it; const float* W; bf16* WT; int K = D, N = D; bool gate = false;
            if (r < 4 * I_UP) { const int l = r / I_UP; W = p.mlp_w1 + (size_t)l * D * FF; N = FF; WT = (bf16*)(ws + WS_W1) + (size_t)l * D * FF; r %= I_UP; }
            else if ((r -= 4 * I_UP) < 4 * I_DN) { const int l = r / I_DN; W = p.mlp_w2 + (size_t)l * D * FF; K = FF; WT = (bf16*)(ws + WS_W2) + (size_t)l * D * FF; r %= I_DN; }
            else if ((r -= 4 * I_DN) < 2 * I_AIN) { const int l = r / I_AIN; W = p.a_w_in + (size_t)l * D * 3072; N = 3072; WT = (bf16*)(ws + WS_AIN) + (size_t)l * 3328 * D; r %= I_AIN; }
            else if ((r -= 2 * I_AIN) < 2 * I_GATE) { const int l = r / I_GATE; W = p.a_w_gate + (size_t)l * D * 32; N = 32; WT = (bf16*)(ws + WS_AIN) + (size_t)l * 3328 * D; gate = true; r %= I_GATE; }
            else if ((r -= 2 * I_GATE) < 2 * I_SQ) { const int l = r / I_SQ; W = p.a_w_out + (size_t)l * D * D; WT = (bf16*)(ws + WS_AOUT) + (size_t)l * D * D; r %= I_SQ; }
            else if ((r -= 2 * I_SQ) < I_BQ) { W = p.b_w_qkv; N = 1536; WT = (bf16*)(ws + WS_BQKV); }
            else if ((r -= I_BQ) < I_SQ) { W = p.b_w_out; WT = (bf16*)(ws + WS_BOUT); }
            else if ((r -= I_SQ) < I_AIN) { W = p.c_w_in; N = 3072; WT = (bf16*)(ws + WS_CIN); }
            else { r -= I_AIN; W = p.c_w_out; WT = (bf16*)(ws + WS_COUT); }
            if (gate) p0_transpose_item(W, K, N, WT, 3072, (LAS float*)scr, r, lane);
            else p0_transpose64(W, K, N, WT, scr, r, lane);
        }
    }
}

__device__ __forceinline__ void phase_norm(const Params& p, const float* hlat, const float* hcsrc, int nrows, const float* g, const float* shift, const float* scale, int nparts) {
    FRESH_IDS();
    const int gw = blockIdx.x * NWAVES + wave, NGW = gridDim.x * NWAVES;
    float* hc = (float*)(p.ws + WS_HC); bf16* xn = (bf16*)(p.ws + WS_XN);
    for (int row0 = gw; row0 < nrows; row0 += 2 * NGW) {
        const int row1 = row0 + NGW; const bool has1 = row1 < nrows; const int rowb = has1 ? row1 : row0;
        const float* src0 = row0 < ML ? hlat + (size_t)row0 * D : hcsrc + (size_t)(row0 - ML) * D;
        const float* src1 = rowb < ML ? hlat + (size_t)rowb * D : hcsrc + (size_t)(rowb - ML) * D;
        const f32x4* xr0 = (const f32x4*)src0 + lane; const f32x4* xr1 = (const f32x4*)src1 + lane;
        f32x4 v0[4], v1[4]; float s0 = 0.f, s1 = 0.f;
#pragma unroll
        for (int j = 0; j < 4; ++j) { v0[j] = xr0[64 * j]; v1[j] = xr1[64 * j]; }
        if (nparts > 0) {
            const float* part = (const float*)(p.ws + WS_PART);
            if (row0 >= ML) { f32x4* hw = (f32x4*)(hc + (size_t)(row0 - ML) * D) + lane;
                for (int k = 0; k < nparts; ++k) { const f32x4* pr = (const f32x4*)(part + ((size_t)k * 512 + (row0 - ML)) * D) + lane;
#pragma unroll
                    for (int j = 0; j < 4; ++j) v0[j] += pr[64 * j]; }
#pragma unroll
                for (int j = 0; j < 4; ++j) hw[64 * j] = v0[j]; }
            if (has1 && row1 >= ML) { f32x4* hw = (f32x4*)(hc + (size_t)(row1 - ML) * D) + lane;
                for (int k = 0; k < nparts; ++k) { const f32x4* pr = (const f32x4*)(part + ((size_t)k * 512 + (row1 - ML)) * D) + lane;
#pragma unroll
                    for (int j = 0; j < 4; ++j) v1[j] += pr[64 * j]; }
#pragma unroll
                for (int j = 0; j < 4; ++j) hw[64 * j] = v1[j]; }
        }
#pragma unroll
        for (int j = 0; j < 4; ++j) { s0 += (v0[j].x * v0[j].x + v0[j].y * v0[j].y) + (v0[j].z * v0[j].z + v0[j].w * v0[j].w); s1 += (v1[j].x * v1[j].x + v1[j].y * v1[j].y) + (v1[j].z * v1[j].z + v1[j].w * v1[j].w); }
        const float rs0 = __builtin_amdgcn_rsqf(wave_sum(s0, lane) * (1.f / D) + 1e-6f), rs1 = __builtin_amdgcn_rsqf(wave_sum(s1, lane) * (1.f / D) + 1e-6f);
        const int r0 = row0 < ML ? (row0 >> 13) : 2, r1 = rowb < ML ? (rowb >> 13) : 2;
        unsigned long long* o0 = (unsigned long long*)(xn + (size_t)row0 * D) + lane; unsigned long long* o1 = (unsigned long long*)(xn + (size_t)rowb * D) + lane;
#pragma unroll
        for (int j = 0; j < 4; ++j) { const int col = 4 * lane + 256 * j;
            const f32x4 gg = *(const f32x4*)(g + col);
            { const f32x4 sh = *(const f32x4*)(shift + r0 * 6144 + col), sc = *(const f32x4*)(scale + r0 * 6144 + col);
              const f32x4 y = (v0[j] * rs0) * gg * (sc + 1.0f) + sh;
              o0[64 * j] = (unsigned long long)pk2(y.x, y.y) | ((unsigned long long)pk2(y.z, y.w) << 32); }
            if (has1) { const f32x4 sh = *(const f32x4*)(shift + r1 * 6144 + col), sc = *(const f32x4*)(scale + r1 * 6144 + col);
              const f32x4 y = (v1[j] * rs1) * gg * (sc + 1.0f) + sh;
              o1[64 * j] = (unsigned long long)pk2(y.x, y.y) | ((unsigned long long)pk2(y.z, y.w) << 32); }
        }
    }
}
__device__ __forceinline__ void phase_final_norm(const Params& p) {
    FRESH_IDS();
    const int gw = blockIdx.x * NWAVES + wave, NGW = gridDim.x * NWAVES;
    for (int row = gw; row < ML; row += NGW) {
        f32x4* xr = (f32x4*)(p.out + (size_t)row * D) + lane;
        f32x4 v[4]; float s = 0.f;
#pragma unroll
        for (int j = 0; j < 4; ++j) { v[j] = xr[64 * j]; s += (v[j].x * v[j].x + v[j].y * v[j].y) + (v[j].z * v[j].z + v[j].w * v[j].w); }
        const float rs = __builtin_amdgcn_rsqf(wave_sum(s, lane) * (1.f / D) + 1e-6f);
#pragma unroll
        for (int j = 0; j < 4; ++j) { const f32x4 gg = *(const f32x4*)(p.final_g + 4 * lane + 256 * j); xr[64 * j] = (v[j] * rs) * gg; }
    }
}

__device__ __forceinline__ void phase_conv(const Params& p, int nrows) {
    FRESH_IDS();
    const bf16* P = (const bf16*)(p.ws + WS_ACT); bf16* Z = (bf16*)(p.ws + WS_HG);
    const int gt = blockIdx.x * NTHR + tid, GT = gridDim.x * NTHR;
    const int ch = (gt & 127) * 8;
    f32x4 cw[3][2], cb[2];
#pragma unroll
    for (int h = 0; h < 2; ++h) { cb[h] = *(const f32x4*)(p.c_conv_b + ch + 4 * h);
#pragma unroll
        for (int w = 0; w < 3; ++w) cw[w][h] = *(const f32x4*)(p.c_conv_w + w * 1024 + ch + 4 * h); }
    for (int q = gt >> 7; q < nrows / 4; q += GT >> 7) {
        const int row0 = 4 * q;
        bool hp, hn;
        if (row0 < ML) { const int s0 = row0 & (SEQ - 1); hp = s0 > 0; hn = s0 + 4 < SEQ; } else { const int t0 = (row0 - ML) & (CTXL - 1); hp = t0 > 0; hn = t0 + 4 < CTXL; }
        const bf16* pr = P + (size_t)row0 * 3072 + ch;
        v4u cg[6], xt[6], bgv[4];
#pragma unroll
        for (int i = 0; i < 6; ++i) { const bool ok = (i == 0) ? hp : ((i == 5) ? hn : true);
            if (ok) { cg[i] = *(const v4u*)(pr + (ptrdiff_t)(i - 1) * 3072 + 1024); xt[i] = *(const v4u*)(pr + (ptrdiff_t)(i - 1) * 3072 + 2048); }
            else { cg[i] = (v4u){0u, 0u, 0u, 0u}; xt[i] = cg[i]; } }
#pragma unroll
        for (int i = 0; i < 4; ++i) bgv[i] = *(const v4u*)(pr + (size_t)i * 3072);
        float u[6][8];
#pragma unroll
        for (int i = 0; i < 6; ++i)
#pragma unroll
            for (int e2 = 0; e2 < 4; ++e2) { u[i][2 * e2] = bflo(cg[i][e2]) * bflo(xt[i][e2]); u[i][2 * e2 + 1] = bfhi(cg[i][e2]) * bfhi(xt[i][e2]); }
#pragma unroll
        for (int i = 0; i < 4; ++i) { v4u o;
#pragma unroll
            for (int e2 = 0; e2 < 4; ++e2) { const int e = 2 * e2, h = e >> 2, k = e & 3;
                const float a0 = cb[h][k] + cw[0][h][k] * u[i][e] + cw[1][h][k] * u[i + 1][e] + cw[2][h][k] * u[i + 2][e];
                const float a1 = cb[h][k + 1] + cw[0][h][k + 1] * u[i][e + 1] + cw[1][h][k + 1] * u[i + 1][e + 1] + cw[2][h][k + 1] * u[i + 2][e + 1];
                o[e2] = pk2(bflo(bgv[i][e2]) * a0, bfhi(bgv[i][e2]) * a1); }
            *(v4u*)(Z + (size_t)(row0 + i) * 1024 + ch) = o; }
    }
}

__device__ __forceinline__ void mlstm_scan(const float* lf, const float* li, float* bo, float* gso, float* mco, float mprev, bool bwd, int lane) {
    const int i0 = bwd ? 127 - 2 * lane : 2 * lane, i1 = bwd ? 126 - 2 * lane : 2 * lane + 1;
    const float a0 = lf[i0], a1 = lf[i1];
    float s = a0 + a1;
#pragma unroll
    for (int o = 1; o < 64; o <<= 1) { const float t = shup(s, o, lane); if (lane >= o) s += t; }
    const float b0 = s - a1, b1 = s;
    bo[i0] = b0; bo[i1] = b1;
    const float g0 = li[i0] - b0, g1 = li[i1] - b1;
    if (gso) { gso[i0] = g0; gso[i1] = g1; }
    if (mco) {
        float pm = fmaxf(g0, g1);
#pragma unroll
        for (int o = 1; o < 64; o <<= 1) { const float t = shup(pm, o, lane); if (lane >= o) pm = fmaxf(pm, t); }
        float pe = shup(pm, 1, lane); if (lane == 0) pe = NEG_BIG;
        const float m0 = fmaxf(pe, g0), m1 = fmaxf(m0, g1);
        mco[i0] = b0 + fmaxf(mprev, m0); mco[i1] = b1 + fmaxf(mprev, m1);
    }
}

__device__ __forceinline__ void phase_mlstm_local(const Params& p, unsigned char* lds) {
    FRESH_IDS();
    const bf16* P = (const bf16*)(p.ws + WS_ACT); const float* Gt = (const float*)(p.ws + WS_G);
    float* dC = (float*)(p.ws + WS_DC); float* dN = (float*)(p.ws + WS_DN);
    float* mloc = (float*)(p.ws + WS_MISC); float* bend = mloc + 32 * NCH;
    bf16* Vt = (bf16*)lds; bf16* Ktf = (bf16*)(lds + 34816); bf16* Ktb = (bf16*)(lds + 52224);
    float* fl = (float*)(lds + 69632);
    float *lif = fl, *lff = fl + 128, *lib = fl + 256, *lfb = fl + 384, *bfw = fl + 512, *bbw = fl + 640, *wsf = fl + 768, *wsb = fl + 896;
    const int fr = lane & 15, fq = lane >> 4;
    for (int item = blockIdx.x; item < NBATCH * 8 * NCH; item += gridDim.x) {
        int tix = tid; asm volatile("" : "+v"(tix));
        const int b = item / (8 * NCH), hd = (item / NCH) % 8, j = item % NCH;
        const int row0 = chunk_row(b, j);
        const int chain0 = (b * 8 + hd) * 2;
        int ll = tix & 63; const int fr = ll & 15, fq = ll >> 4;
        __syncthreads();
        if (tix < 128) { const float* g = Gt + (size_t)(row0 + tix) * 32; lif[tix] = g[hd]; lff[tix] = logsig(g[8 + hd]); lib[tix] = g[16 + hd]; lfb[tix] = logsig(g[24 + hd]); }
        __syncthreads();
        if (wave < 2) {
            const bool bw = wave == 1;
            mlstm_scan(bw ? lfb : lff, bw ? lib : lif, bw ? bbw : bfw, nullptr, nullptr, 0.f, bw, lane);
            asm volatile("s_waitcnt lgkmcnt(0)" ::: "memory");
            const float* bb_ = bw ? bbw : bfw; const float* li_ = bw ? lib : lif; float* ws_ = bw ? wsb : wsf;
            const float be = bw ? bb_[0] : bb_[127];
            const float w0 = be - bb_[lane] + li_[lane], w1 = be - bb_[lane + 64] + li_[lane + 64];
            const float mx = wave_max(fmaxf(w0, w1), lane);
            ws_[lane] = __expf(w0 - mx); ws_[lane + 64] = __expf(w1 - mx);
            if (lane == 0) { mloc[(chain0 + wave) * NCH + j] = mx; bend[(chain0 + wave) * NCH + j] = be; }
        }
        __syncthreads();
        for (int c = tix; c < 2048; c += NTHR) { const int s = c & 127, ch = c >> 7;
            const v4u v = *(const v4u*)(P + (size_t)(row0 + s) * 3072 + 1024 + hd * 128 + ch * 8);
#pragma unroll
            for (int e2 = 0; e2 < 4; ++e2) { Vt[(ch * 8 + 2 * e2) * 136 + s] = (bf16)(v[e2] & 0xffffu); Vt[(ch * 8 + 2 * e2 + 1) * 136 + s] = (bf16)(v[e2] >> 16); } }
        for (int c = tix; c < 1024; c += NTHR) { const int s = c & 127, ch = c >> 7;
            const v4u v = *(const v4u*)(P + (size_t)(row0 + s) * 3072 + 512 + hd * 64 + ch * 8);
            const float wf = wsf[s], wb = wsb[s];
#pragma unroll
            for (int e2 = 0; e2 < 4; ++e2) { const float k0 = bflo(v[e2]), k1 = bfhi(v[e2]);
                const unsigned pf_ = pk2(k0 * wf, k1 * wf), pb_ = pk2(k0 * wb, k1 * wb);
                Ktf[(ch * 8 + 2 * e2) * 136 + s] = (bf16)(pf_ & 0xffffu); Ktf[(ch * 8 + 2 * e2 + 1) * 136 + s] = (bf16)(pf_ >> 16);
                Ktb[(ch * 8 + 2 * e2) * 136 + s] = (bf16)(pb_ & 0xffffu); Ktb[(ch * 8 + 2 * e2 + 1) * 136 + s] = (bf16)(pb_ >> 16); } }
        __syncthreads();
#pragma unroll
        for (int dir = 0; dir < 2; ++dir) {
            const bf16* Kt = dir ? Ktb : Ktf;
            f32x4 acc[4];
#pragma unroll
            for (int nt = 0; nt < 4; ++nt) acc[nt] = (f32x4){0.f, 0.f, 0.f, 0.f};
#pragma unroll
            for (int ks = 0; ks < 4; ++ks) { const bf16x8 a = *(const bf16x8*)(Vt + (16 * wave + fr) * 136 + 32 * ks + 8 * fq);
#pragma unroll
                for (int nt = 0; nt < 4; ++nt) { const bf16x8 bb = *(const bf16x8*)(Kt + (16 * nt + fr) * 136 + 32 * ks + 8 * fq); acc[nt] = MFMA16(a, bb, acc[nt]); } }
            float* dst = dC + ((size_t)(chain0 + dir) * NCH + j) * 8192;
#pragma unroll
            for (int nt = 0; nt < 4; ++nt)
#pragma unroll
                for (int r = 0; r < 4; ++r) dst[(16 * wave + 4 * fq + r) * 64 + 16 * nt + fr] = acc[nt][r];
        }
        if (tix < 128) { const int dir = tix >> 6, dk = tix & 63; const bf16* Kt = (dir ? Ktb : Ktf) + dk * 136; float s = 0.f;
            for (int i = 0; i < 128; ++i) s += bf2f(Kt[i]);
            dN[((size_t)(chain0 + dir) * NCH + j) * 64 + dk] = s; }
    }
}

__device__ __forceinline__ void phase_mlstm_scan(const Params& p) {
    FRESH_IDS();
    const float* dC = (const float*)(p.ws + WS_DC); float* dN = (float*)(p.ws + WS_DN); unsigned* CP = (unsigned*)(p.ws + WS_CP);
    const float* mloc = (const float*)(p.ws + WS_MISC); const float* bend = mloc + 32 * NCH; float* mprev = (float*)(p.ws + WS_MISC) + 2 * 32 * NCH;
    const int GT = gridDim.x * NTHR;
    for (int idx = blockIdx.x * NTHR + tid; idx < 32 * 4096; idx += GT) {
        const int chain = idx >> 12, e = idx & 4095, dir = chain & 1;
        const float2* src = (const float2*)(dC + (size_t)chain * NCH * 8192) + e;
        unsigned* dst = CP + (size_t)chain * NCH * 4096 + e;
        float2* nsrc = (float2*)(dN + (size_t)chain * NCH * 64) + e;
        const bool don = e < 32;
        float zz = 0.f; asm volatile("" : "+v"(zz));
        float m = NEG_BIG; float2 C = make_float2(zz, zz), n = make_float2(zz, zz);
        for (int pb = 0; pb < NCH; pb += 11) {
            float2 xv[11], nv[11]; float ml[11], be[11];
#pragma unroll
            for (int u = 0; u < 11; ++u) { const int pp = pb + u; const int j = dir ? (pp < 2 ? 1 - pp : 67 - pp) : pp;
                xv[u] = src[(size_t)j * 4096]; ml[u] = mloc[chain * NCH + j]; be[u] = bend[chain * NCH + j];
                nv[u] = don ? nsrc[j * 32] : make_float2(0.f, 0.f); }
#pragma unroll
            for (int u = 0; u < 11; ++u) { const int pp = pb + u; const int j = dir ? (pp < 2 ? 1 - pp : 67 - pp) : pp;
                dst[(size_t)j * 4096] = pk2(C.x, C.y);
                if (don) nsrc[j * 32] = n;
                if (e == 0) mprev[chain * NCH + j] = m;
                const float mn = fmaxf(be[u] + m, ml[u]);
                const float dcy = __expf(be[u] + m - mn), w = __expf(ml[u] - mn);
                C.x = dcy * C.x + w * xv[u].x; C.y = dcy * C.y + w * xv[u].y;
                n.x = dcy * n.x + w * nv[u].x; n.y = dcy * n.y + w * nv[u].y;
                m = mn; }
        }
    }
}

__device__ __forceinline__ void phase_mlstm_out(const Params& p, unsigned char* lds, int lyr_a, bool ctx_out) {
    FRESH_IDS();
    const bf16* P = (const bf16*)(p.ws + WS_ACT); const float* Gt = (const float*)(p.ws + WS_G);
    const float* nP = (const float*)(p.ws + WS_DN); const bf16* CP = (const bf16*)(p.ws + WS_CP);
    const float* mprev = (const float*)(p.ws + WS_MISC) + 2 * 32 * NCH;
    const float* head_g = p.a_head_g + lyr_a * 1024;
    bf16* HG = (bf16*)(p.ws + WS_HG);
    bf16* Qs = (bf16*)lds; bf16* Ks = (bf16*)(lds + 18432); bf16* Vt = (bf16*)(lds + 36864); bf16* Ct = (bf16*)(lds + 71680);
    float* fl = (float*)(lds + 106496);
    float *bfw = fl, *bbw = fl + 128, *gsf = fl + 256, *gsb = fl + 384, *mcf = fl + 512, *mcb = fl + 640, *lif = fl + 768, *lff = fl + 896, *lib = fl + 1024, *lfb = fl + 1152, *nf = fl + 1280, *nb = fl + 1344;
    const int fr = lane & 15, fq = lane >> 4;
    const int jlo = ctx_out ? 0 : 2, nj = NCH - jlo;
    const int nitems = NBATCH * 8 * nj;
    v4u rq[2], rk[2], rv[4], rc[4]; float rg0 = 0.f, rg1 = 0.f, rg2 = 0.f, rg3 = 0.f, rn = 0.f, rmf = 0.f, rmb = 0.f;
#define P5_PREFETCH(it_) do { const int b_ = (it_) / (8 * nj), hd_ = ((it_) / nj) % 8, j_ = jlo + (it_) % nj; const int row0_ = chunk_row(b_, j_), chain0_ = (b_ * 8 + hd_) * 2; \
        rmf = mprev[(chain0_ + 0) * NCH + j_]; rmb = mprev[(chain0_ + 1) * NCH + j_]; \
        if (tix < 128) { const float* g_ = Gt + (size_t)(row0_ + tix) * 32; rg0 = g_[hd_]; rg1 = g_[8 + hd_]; rg2 = g_[16 + hd_]; rg3 = g_[24 + hd_]; \
            rn = nP[((size_t)(chain0_ + (tix >> 6)) * NCH + j_) * 64 + (tix & 63)]; } \
        _Pragma("unroll") for (int i = 0; i < 2; ++i) { const int c = tix + i * NTHR, r = c >> 3, ch = c & 7; \
            rq[i] = *(const v4u*)(P + (size_t)(row0_ + r) * 3072 + hd_ * 64 + ch * 8); rk[i] = *(const v4u*)(P + (size_t)(row0_ + r) * 3072 + 512 + hd_ * 64 + ch * 8); } \
        _Pragma("unroll") for (int i = 0; i < 4; ++i) { const int c = tix + i * NTHR; \
            rv[i] = *(const v4u*)(P + (size_t)(row0_ + (c & 127)) * 3072 + 1024 + hd_ * 128 + (c >> 7) * 8); \
            rc[i] = *(const v4u*)(CP + ((size_t)(chain0_ + (c >> 10)) * NCH + j_) * 8192 + ((c >> 3) & 127) * 64 + (c & 7) * 8); } } while (0)
    { int tix = tid; asm volatile("" : "+v"(tix)); if ((int)blockIdx.x < nitems) P5_PREFETCH((int)blockIdx.x); }
    for (int item = blockIdx.x; item < nitems; item += gridDim.x) {
        int tix = tid; asm volatile("" : "+v"(tix));
        const int b = item / (8 * nj), hd = (item / nj) % 8, j = jlo + item % nj;
        const int row0 = chunk_row(b, j);
        const int chain0 = (b * 8 + hd) * 2;
        int ll = tix & 63; const int fr = ll & 15, fq = ll >> 4;
        const float m_f = rmf, m_b = rmb;
        asm volatile("s_waitcnt lgkmcnt(0)" ::: "memory"); __builtin_amdgcn_s_barrier(); asm volatile("" ::: "memory");
        if (tix < 128) { lif[tix] = rg0; lff[tix] = logsig(rg1); lib[tix] = rg2; lfb[tix] = logsig(rg3); ((tix >> 6) ? nb : nf)[tix & 63] = rn; }
#pragma unroll
        for (int i = 0; i < 2; ++i) { const int c = tix + i * NTHR, r = c >> 3, ch = c & 7;
            *(v4u*)(Qs + r * 72 + ch * 8) = rq[i]; *(v4u*)(Ks + r * 72 + ch * 8) = rk[i]; }
#pragma unroll
        for (int i = 0; i < 4; ++i) { const int c = tix + i * NTHR; const int s = c & 127, ch = c >> 7; const v4u v = rv[i];
#pragma unroll
            for (int e2 = 0; e2 < 4; ++e2) { Vt[(ch * 8 + 2 * e2) * 136 + s] = (bf16)(v[e2] & 0xffffu); Vt[(ch * 8 + 2 * e2 + 1) * 136 + s] = (bf16)(v[e2] >> 16); }
            const int dir = c >> 10, dv = (c >> 3) & 127, ch2 = c & 7;
            *(v4u*)(Ct + dv * 136 + dir * 64 + ch2 * 8) = rc[i]; }
        asm volatile("s_waitcnt lgkmcnt(0)" ::: "memory"); __builtin_amdgcn_s_barrier(); asm volatile("" ::: "memory");
        if (wave == 0) mlstm_scan(lff, lif, bfw, gsf, mcf, m_f, false, lane);
        else if (wave == 1) mlstm_scan(lfb, lib, bbw, gsb, mcb, m_b, true, lane);
        asm volatile("s_waitcnt lgkmcnt(0)" ::: "memory"); __builtin_amdgcn_s_barrier(); asm volatile("" ::: "memory");
        if (item + (int)gridDim.x < nitems) P5_PREFETCH(item + (int)gridDim.x);
        const int t = 16 * wave + fr;
        const float btf = bfw[t], mcft = mcf[t], btb = bbw[t], mcbt = mcb[t];
        const float af = __expf(btf + m_f - mcft), ab = __expf(btb + m_b - mcbt);
        float qnf = 0.f, qnb = 0.f;
#pragma unroll
        for (int i = 0; i < 16; ++i) { const int dk = 16 * fq + i; const float qv = bf2f(Qs[t * 72 + dk]); qnf += qv * nf[dk]; qnb += qv * nb[dk]; }
        qnf += shx(qnf, 16, ll); qnf += shx(qnf, 32, ll); qnb += shx(qnb, 16, ll); qnb += shx(qnb, 32, ll);
        qnf *= 0.125f; qnb *= 0.125f;
        bf16x8 bq[2];
#pragma unroll
        for (int ks = 0; ks < 2; ++ks) bq[ks] = *(const bf16x8*)(Qs + t * 72 + 32 * ks + 8 * fq);
        f32x4 scf[8], scb[8]; float sumf = 0.f, sumb = 0.f;
#pragma unroll
        for (int st = 0; st < 8; ++st) {
            f32x4 acc = (f32x4){0.f, 0.f, 0.f, 0.f};
#pragma unroll
            for (int ks = 0; ks < 2; ++ks) { const bf16x8 a = *(const bf16x8*)(Ks + (16 * st + fr) * 72 + 32 * ks + 8 * fq); acc = MFMA16(a, bq[ks], acc); }
            const f32x4 gf4 = *(const f32x4*)(gsf + 16 * st + 4 * fq), gb4 = *(const f32x4*)(gsb + 16 * st + 4 * fq);
#pragma unroll
            for (int r = 0; r < 4; ++r) { const int s = 16 * st + 4 * fq + r; const float sv = acc[r] * 0.125f;
                const float df = (s <= t) ? __expf(btf + gf4[r] - mcft) : 0.f, db = (s >= t) ? __expf(btb + gb4[r] - mcbt) : 0.f;
                scf[st][r] = sv * df; scb[st][r] = sv * db; sumf += scf[st][r]; sumb += scb[st][r]; }
        }
        sumf += shx(sumf, 16, ll); sumf += shx(sumf, 32, ll); sumb += shx(sumb, 16, ll); sumb += shx(sumb, 32, ll);
        const float rf = __builtin_amdgcn_rcpf(fmaxf(fabsf(sumf + af * qnf), __expf(-mcft))), rb = __builtin_amdgcn_rcpf(fmaxf(fabsf(sumb + ab * qnb), __expf(-mcbt)));
        bf16x8 pf[4], qf[4];
#pragma unroll
        for (int kp = 0; kp < 4; ++kp) { v4u w;
            w.x = pk2(scf[2 * kp][0] * rf + scb[2 * kp][0] * rb, scf[2 * kp][1] * rf + scb[2 * kp][1] * rb);
            w.y = pk2(scf[2 * kp][2] * rf + scb[2 * kp][2] * rb, scf[2 * kp][3] * rf + scb[2 * kp][3] * rb);
            w.z = pk2(scf[2 * kp + 1][0] * rf + scb[2 * kp + 1][0] * rb, scf[2 * kp + 1][1] * rf + scb[2 * kp + 1][1] * rb);
            w.w = pk2(scf[2 * kp + 1][2] * rf + scb[2 * kp + 1][2] * rb, scf[2 * kp + 1][3] * rf + scb[2 * kp + 1][3] * rb);
            pf[kp] = __builtin_bit_cast(bf16x8, w); }
#pragma unroll
        for (int ks = 0; ks < 4; ++ks) { const float scl = 0.125f * ((ks >> 1) ? ab * rb : af * rf);
            const v4u qr = *(const v4u*)(Qs + t * 72 + 32 * (ks & 1) + 8 * fq); v4u w;
#pragma unroll
            for (int e2 = 0; e2 < 4; ++e2) w[e2] = pk2(bflo(qr[e2]) * scl, bfhi(qr[e2]) * scl);
            qf[ks] = __builtin_bit_cast(bf16x8, w); }
        const size_t row = (size_t)(row0 + t);
        v2u ovp[8];
#pragma unroll
        for (int dt = 0; dt < 8; ++dt) ovp[dt] = *(const v2u*)(P + row * 3072 + 2048 + hd * 128 + 16 * dt + 4 * fq);
        f32x4 hacc[8]; float ss = 0.f;
#pragma unroll
        for (int dt = 0; dt < 8; ++dt) {
            f32x4 acc = (f32x4){0.f, 0.f, 0.f, 0.f};
#pragma unroll
            for (int kp = 0; kp < 4; ++kp) { v4u aw; const v2u lo = *(const v2u*)(Vt + (16 * dt + fr) * 136 + 32 * kp + 4 * fq), hi = *(const v2u*)(Vt + (16 * dt + fr) * 136 + 32 * kp + 16 + 4 * fq);
                aw.x = lo.x; aw.y = lo.y; aw.z = hi.x; aw.w = hi.y; acc = MFMA16(__builtin_bit_cast(bf16x8, aw), pf[kp], acc); }
#pragma unroll
            for (int ks = 0; ks < 4; ++ks) { const bf16x8 a = *(const bf16x8*)(Ct + (16 * dt + fr) * 136 + 32 * ks + 8 * fq); acc = MFMA16(a, qf[ks], acc); }
            hacc[dt] = acc; ss += (acc[0] * acc[0] + acc[1] * acc[1]) + (acc[2] * acc[2] + acc[3] * acc[3]);
        }
        ss += shx(ss, 16, ll); ss += shx(ss, 32, ll);
        const float rn = __builtin_amdgcn_rsqf(ss * (1.f / 128.f) + 1e-6f);
#pragma unroll
        for (int dt = 0; dt < 8; ++dt) { const int dv0 = 16 * dt + 4 * fq;
            const v2u ov = ovp[dt]; const f32x4 hg4 = *(const f32x4*)(head_g + hd * 128 + dv0);
            const float o0 = bflo(ov.x), o1 = bfhi(ov.x), o2 = bflo(ov.y), o3 = bfhi(ov.y);
            const float y0 = hacc[dt][0] * rn * hg4[0] * __builtin_amdgcn_rcpf(1.f + __expf(-o0)), y1 = hacc[dt][1] * rn * hg4[1] * __builtin_amdgcn_rcpf(1.f + __expf(-o1));
            const float y2 = hacc[dt][2] * rn * hg4[2] * __builtin_amdgcn_rcpf(1.f + __expf(-o2)), y3 = hacc[dt][3] * rn * hg4[3] * __builtin_amdgcn_rcpf(1.f + __expf(-o3));
            v2u w; w.x = pk2(y0, y1); w.y = pk2(y2, y3);
            *(v2u*)(HG + row * 1024 + hd * 128 + dv0) = w; }
    }
}

#undef P5_PREFETCH
__device__ __forceinline__ void phase_attn(const Params& p, unsigned char* lds, bool ctx_out) {
    FRESH_IDS();
    const bf16* Pq = (const bf16*)(p.ws + WS_ACT); bf16* AO = (bf16*)(p.ws + WS_HG);
    bf16* Ks = (bf16*)lds; bf16* Vt = (bf16*)(lds + 18432);
    const int fr = lane & 15, fq = lane >> 4;
    const int nitems = 512 + (ctx_out ? 16 : 0);
    const int vb0 = ((int)gridDim.x & 7) == 0 ? ((int)blockIdx.x & 7) * ((int)gridDim.x >> 3) + ((int)blockIdx.x >> 3) : (int)blockIdx.x;
    for (int item = vb0; item < nitems; item += gridDim.x) {
        int tix = tid; asm volatile("" : "+v"(tix));
        int b, g, qrow0, nblk = 0; bool lat = item < 512;
        if (lat) { b = item >> 8; g = (item >> 6) & 3; nblk = item & 63; qrow0 = b * SEQ + nblk * 128; }
        else { const int ci = item - 512; b = ci >> 3; g = (ci >> 1) & 3; qrow0 = ML + b * CTXL + (ci & 1) * 128; }
        const int hq = g * 4 + (wave >> 1), tbase = (wave & 1) * 64;
        const float sink = p.b_sinks[hq] * 1.4426950408889634f;
        unsigned char* Qw = lds + 36864 + wave * 8192;
        { const int l0 = tix & 63, fr0 = l0 & 15, fq0 = l0 >> 4;
#pragma unroll
          for (int tt = 0; tt < 4; ++tt)
#pragma unroll
              for (int ks = 0; ks < 2; ++ks) *(v4u*)(Qw + ((tt * 2 + ks) * 64 + l0) * 16) = *(const v4u*)(Pq + (size_t)(qrow0 + tbase + 16 * tt + fr0) * 1536 + hq * 64 + 32 * ks + 8 * fq0); }
        float mrun[4], lrun[4]; f32x4 oacc[4][4];
#pragma unroll
        for (int tt = 0; tt < 4; ++tt) { mrun[tt] = sink; lrun[tt] = (fq == 0) ? 1.f : 0.f;
#pragma unroll
            for (int dt = 0; dt < 4; ++dt) oacc[tt][dt] = (f32x4){0.f, 0.f, 0.f, 0.f}; }
        for (int c = 0; c < 5; ++c) {
            int krow0, mtype = 0;
            if (lat) {
                if (c == 0) { if (nblk == 0) continue; krow0 = qrow0 - 128; mtype = 1; }
                else if (c == 1) { krow0 = qrow0; }
                else if (c == 2) { if (nblk == 63) continue; krow0 = qrow0 + 128; mtype = 2; }
                else { krow0 = ML + b * CTXL + (c - 3) * 128; }
            } else { if (c < 3) continue; krow0 = ML + b * CTXL + (c - 3) * 128; }
            __syncthreads();
            int ll = tix & 63; asm volatile("" : "+v"(ll)); const int fr = ll & 15, fq = ll >> 4;
            for (int cc = tix; cc < 1024; cc += NTHR) { const int r = cc >> 3, ch = cc & 7;
                *(v4u*)(Ks + r * 72 + ch * 8) = *(const v4u*)(Pq + (size_t)(krow0 + r) * 1536 + 1024 + g * 64 + ch * 8); }
            for (int cc = tix; cc < 1024; cc += NTHR) { const int s = cc & 127, ch = cc >> 7;
                const v4u v = *(const v4u*)(Pq + (size_t)(krow0 + s) * 1536 + 1280 + g * 64 + ch * 8);
#pragma unroll
                for (int e2 = 0; e2 < 4; ++e2) { Vt[(ch * 8 + 2 * e2) * 136 + s] = (bf16)(v[e2] & 0xffffu); Vt[(ch * 8 + 2 * e2 + 1) * 136 + s] = (bf16)(v[e2] >> 16); } }
            __syncthreads();
#pragma unroll
            for (int tp = 0; tp < 2; ++tp) {
                bf16x8 bq[2][2]; f32x4 sa[2][8]; float mx[2] = {NEG_BIG, NEG_BIG};
#pragma unroll
                for (int h = 0; h < 2; ++h)
#pragma unroll
                    for (int ks = 0; ks < 2; ++ks) bq[h][ks] = *(const bf16x8*)(Qw + (((2 * tp + h) * 2 + ks) * 64 + ll) * 16);
#pragma unroll
                for (int st = 0; st < 8; ++st) {
                    bool dead[2];
#pragma unroll
                    for (int h = 0; h < 2; ++h) { const int q0 = tbase + 16 * (2 * tp + h); dead[h] = (mtype == 1) ? (16 * st + 15 < q0) : ((mtype == 2) ? (16 * st > q0 + 15) : false); }
                    if (dead[0] && dead[1]) { sa[0][st] = (f32x4){NEG_BIG, NEG_BIG, NEG_BIG, NEG_BIG}; sa[1][st] = sa[0][st]; continue; }
                    bf16x8 kf[2];
#pragma unroll
                    for (int ks = 0; ks < 2; ++ks) kf[ks] = *(const bf16x8*)(Ks + (16 * st + fr) * 72 + 32 * ks + 8 * fq);
#pragma unroll
                    for (int h = 0; h < 2; ++h) {
                        if (dead[h]) { sa[h][st] = (f32x4){NEG_BIG, NEG_BIG, NEG_BIG, NEG_BIG}; continue; }
                        f32x4 acc = (f32x4){0.f, 0.f, 0.f, 0.f};
#pragma unroll
                        for (int ks = 0; ks < 2; ++ks) acc = MFMA16(kf[ks], bq[h][ks], acc);
                        if (mtype != 0) { const int t = tbase + 16 * (2 * tp + h) + fr;
#pragma unroll
                            for (int r = 0; r < 4; ++r) { const int d = (16 * st + 4 * fq + r) - t;
                                const bool ok = (mtype == 1) ? (d >= 0) : (d <= 0);
                                acc[r] = ok ? acc[r] : NEG_BIG; } }
                        mx[h] = fmaxf(fmaxf(mx[h], fmaxf(acc[0], acc[1])), fmaxf(acc[2], acc[3]));
                        sa[h][st] = acc;
                    }
                }
                bf16x8 pf[2][4]; float alpha[2];
#pragma unroll
                for (int h = 0; h < 2; ++h) { const int tt = 2 * tp + h;
                    float m_ = mx[h]; m_ = fmaxf(m_, shx(m_, 16, ll)); m_ = fmaxf(m_, shx(m_, 32, ll));
                    const float mn = fmaxf(mrun[tt], m_); alpha[h] = __builtin_amdgcn_exp2f(mrun[tt] - mn);
                    float ls = 0.f;
#pragma unroll
                    for (int st = 0; st < 8; ++st) {
                        const int q0 = tbase + 16 * tt;
                        const bool dead_ = (mtype == 1) ? (16 * st + 15 < q0) : ((mtype == 2) ? (16 * st > q0 + 15) : false);
                        if (dead_) { sa[h][st] = (f32x4){0.f, 0.f, 0.f, 0.f}; continue; }
#pragma unroll
                        for (int r = 0; r < 4; ++r) { const float pv = __builtin_amdgcn_exp2f(sa[h][st][r] - mn); sa[h][st][r] = pv; ls += pv; } }
                    lrun[tt] = lrun[tt] * alpha[h] + ls; mrun[tt] = mn;
#pragma unroll
                    for (int kp = 0; kp < 4; ++kp) { v4u w; w.x = pk2(sa[h][2 * kp][0], sa[h][2 * kp][1]); w.y = pk2(sa[h][2 * kp][2], sa[h][2 * kp][3]); w.z = pk2(sa[h][2 * kp + 1][0], sa[h][2 * kp + 1][1]); w.w = pk2(sa[h][2 * kp + 1][2], sa[h][2 * kp + 1][3]);
                        pf[h][kp] = __builtin_bit_cast(bf16x8, w); }
                }
#pragma unroll
                for (int dt = 0; dt < 4; ++dt) { f32x4 acc0 = oacc[2 * tp][dt] * alpha[0], acc1 = oacc[2 * tp + 1][dt] * alpha[1];
#pragma unroll
                    for (int kp = 0; kp < 4; ++kp) { v4u aw; const v2u lo = *(const v2u*)(Vt + (16 * dt + fr) * 136 + 32 * kp + 4 * fq), hi = *(const v2u*)(Vt + (16 * dt + fr) * 136 + 32 * kp + 16 + 4 * fq);
                        aw.x = lo.x; aw.y = lo.y; aw.z = hi.x; aw.w = hi.y; const bf16x8 vf = __builtin_bit_cast(bf16x8, aw);
                        acc0 = MFMA16(vf, pf[0][kp], acc0); acc1 = MFMA16(vf, pf[1][kp], acc1); }
                    oacc[2 * tp][dt] = acc0; oacc[2 * tp + 1][dt] = acc1; }
                __builtin_amdgcn_sched_barrier(0);
            }
        }
#pragma unroll
        for (int tt = 0; tt < 4; ++tt) { float lt = lrun[tt]; lt += shx(lt, 16, (tix & 63)); lt += shx(lt, 32, (tix & 63)); const float inv = 1.0f / lt;
            const size_t row = (size_t)(qrow0 + tbase + 16 * tt + fr);
#pragma unroll
            for (int dt = 0; dt < 4; ++dt) { v2u w; w.x = pk2(oacc[tt][dt][0] * inv, oacc[tt][dt][1] * inv); w.y = pk2(oacc[tt][dt][2] * inv, oacc[tt][dt][3] * inv);
                *(v2u*)(AO + row * 1024 + hq * 64 + 16 * dt + 4 * fq) = w; } }
    }
}


__device__ __forceinline__ void ctx_norm_part(const Params& p, const float* g, const float* shift, const float* scale, int nparts, unsigned* ctr) {
    FRESH_IDS();
    if (blockIdx.x < 64) {
        const int row = blockIdx.x * 8 + wave;
        float* hrow = (float*)(p.ws + WS_HC) + (size_t)row * D; bf16* xn = (bf16*)(p.ws + WS_XN) + (size_t)(ML + row) * D;
        const float* part = (const float*)(p.ws + WS_PART);
        f32x4* xr = (f32x4*)hrow + lane; f32x4 v[4];
#pragma unroll
        for (int j = 0; j < 4; ++j) v[j] = xr[64 * j];
        for (int k = 0; k < nparts; ++k) { const f32x4* pr = (const f32x4*)(part + ((size_t)k * 512 + row) * D) + lane;
#pragma unroll
            for (int j = 0; j < 4; ++j) v[j] += pr[64 * j]; }
        float s = 0.f;
#pragma unroll
        for (int j = 0; j < 4; ++j) { if (nparts > 0) xr[64 * j] = v[j]; s += (v[j].x * v[j].x + v[j].y * v[j].y) + (v[j].z * v[j].z + v[j].w * v[j].w); }
        const float rs = __builtin_amdgcn_rsqf(wave_sum(s, lane) * (1.f / D) + 1e-6f);
        unsigned long long* o8 = (unsigned long long*)xn + lane;
#pragma unroll
        for (int j = 0; j < 4; ++j) { const int col = 4 * lane + 256 * j;
            const f32x4 gg = *(const f32x4*)(g + col), sh = *(const f32x4*)(shift + 2 * 6144 + col), sc = *(const f32x4*)(scale + 2 * 6144 + col);
            const f32x4 y = (v[j] * rs) * gg * (sc + 1.0f) + sh;
            o8[64 * j] = (unsigned long long)pk2(y.x, y.y) | ((unsigned long long)pk2(y.z, y.w) << 32); }
        asm volatile("s_waitcnt vmcnt(0)" ::: "memory");
        __syncthreads();
        if (tid == 0) { __builtin_amdgcn_fence(__ATOMIC_RELEASE, "agent"); asm volatile("s_waitcnt vmcnt(0)" ::: "memory"); __hip_atomic_fetch_add(ctr, 1u, __ATOMIC_RELAXED, __HIP_MEMORY_SCOPE_AGENT); }
    }
}
__device__ __forceinline__ void ctx_wait(unsigned* ctr) {
    if (threadIdx.x == 0) { unsigned sp = 0;
        while (__hip_atomic_load(ctr, __ATOMIC_RELAXED, __HIP_MEMORY_SCOPE_AGENT) < 64u) { __builtin_amdgcn_s_sleep(2); if (++sp > (1u << 22)) break; }
        __builtin_amdgcn_fence(__ATOMIC_ACQUIRE, "agent"); asm volatile("s_waitcnt vmcnt(0)" ::: "memory"); }
    __syncthreads();
}

template <int MODE>
__device__ __forceinline__ void ctx_gemm(unsigned char* lds, const bf16* A, const bf16* Bt, int N, int K, int ksplit, bf16* Ob, int ldo, float* Of, const float* vec, float scale0, int scale_cols, unsigned* waitctr,
                                         int row_base = ML, int mtiles = 4, bool fromfront = false) {
    FRESH_IDS();
    const int fr = lane & 15, fq = lane >> 4, G = gridDim.x, bx = blockIdx.x;
    const int ntn = (N + 63) >> 6, ntiles = mtiles * ntn * ksplit, Kp = K / ksplit;
    const int tfirst = fromfront ? bx : G - 1 - bx;
    bf16* As = (bf16*)lds; bf16* Bs = (bf16*)(lds + 67584);
    if (waitctr != nullptr && tfirst < ntiles) ctx_wait(waitctr);
    for (int t = tfirst; t < ntiles; t += G) {
        const int ks = t % ksplit, r = t / ksplit, mt = r % mtiles, ntl = r / mtiles;
        const int n0 = ntl * 64, k0 = ks * Kp;
        const int m0 = mt * 128 + wave * 16;
        const bf16* ag = A + (size_t)(mt * 128 + (tid >> 5)) * K + k0 + 8 * (tid & 31);
        const bf16* bg = Bt + (size_t)(n0 + (tid >> 5)) * K + k0 + 8 * (tid & 31);
        f32x4 acc[4];
#pragma unroll
        for (int nt = 0; nt < 4; ++nt) acc[nt] = (f32x4){0.f, 0.f, 0.f, 0.f};
        v4u ra[8], rb[4];
#pragma unroll
        for (int i = 0; i < 8; ++i) ra[i] = *(const v4u*)(ag + (size_t)i * 16 * K);
#pragma unroll
        for (int i = 0; i < 4; ++i) rb[i] = *(const v4u*)(bg + (size_t)i * 16 * K);
        for (int kk = 0; kk < Kp; kk += 256) {
            __syncthreads();
#pragma unroll
            for (int i = 0; i < 8; ++i) *(v4u*)(As + ((tid >> 5) + 16 * i) * 264 + 8 * (tid & 31)) = ra[i];
#pragma unroll
            for (int i = 0; i < 4; ++i) *(v4u*)(Bs + ((tid >> 5) + 16 * i) * 264 + 8 * (tid & 31)) = rb[i];
            __syncthreads();
            if (kk + 256 < Kp) {
#pragma unroll
                for (int i = 0; i < 8; ++i) ra[i] = *(const v4u*)(ag + (size_t)i * 16 * K + kk + 256);
#pragma unroll
                for (int i = 0; i < 4; ++i) rb[i] = *(const v4u*)(bg + (size_t)i * 16 * K + kk + 256);
            }
#pragma unroll
            for (int j = 0; j < 8; ++j) { const bf16x8 a = *(const bf16x8*)(As + (wave * 16 + fr) * 264 + 32 * j + 8 * fq);
#pragma unroll
                for (int nt = 0; nt < 4; ++nt) { const bf16x8 b = *(const bf16x8*)(Bs + (16 * nt + fr) * 264 + 32 * j + 8 * fq); acc[nt] = MFMA16(b, a, acc[nt]); } }
        }
        const int row = m0 + fr;
#pragma unroll
        for (int nt = 0; nt < 4; ++nt) { const int col = n0 + 16 * nt + 4 * fq; f32x4 v = acc[nt];
            if (MODE == 0) { if (col < scale_cols) v = v * scale0; v2u w; w.x = pk2(v[0], v[1]); w.y = pk2(v[2], v[3]); *(v2u*)(Ob + (size_t)(row_base + row) * ldo + col) = w; }
            else if (MODE == 1) {
#pragma unroll
                for (int e = 0; e < 4; ++e) { const float a = fmaxf(v[e], 0.f); v[e] = a * a; }
                v2u w; w.x = pk2(v[0], v[1]); w.y = pk2(v[2], v[3]); *(v2u*)(Ob + (size_t)(row_base + row) * ldo + col) = w; }
            else if (MODE == 2) {
                if (col < 3072) { v2u w; w.x = pk2(v[0], v[1]); w.y = pk2(v[2], v[3]); *(v2u*)(Ob + (size_t)(row_base + row) * 3072 + col) = w; }
                else if (col < 3104) { *(f32x4*)(Of + (size_t)(row_base + row) * 32 + (col - 3072)) = v + *(const f32x4*)(vec + (col - 3072)); } }
            else if (MODE == 4) { if (col < 32) *(f32x4*)(Of + (size_t)(row_base + row) * 32 + col) = v + *(const f32x4*)(vec + col); }
            else { const f32x4 g = *(const f32x4*)(vec + col); *(f32x4*)(Of + ((size_t)ks * 512 + row) * 1024 + col) = g * v; }
        }
    }
}

#define XB_TMO      128
#define XB_XCNT(j)  (256  + 64 * (j))
#define XB_XSUB(j)  (1280 + 64 * (j))
#define XB_XGEN(j)  (2304 + 64 * (j))
#define XB_TOP      3328
#define XB_TOPGEN   3392
#define XCD_BAR_WORDS 3456
#define XB_SPIN_CAP (1u << 18)

__device__ __forceinline__ unsigned xb_ld(unsigned* p)              { return __hip_atomic_load(p, __ATOMIC_RELAXED, __HIP_MEMORY_SCOPE_AGENT); }
__device__ __forceinline__ unsigned xb_add(unsigned* p, unsigned v) { return __hip_atomic_fetch_add(p, v, __ATOMIC_RELAXED, __HIP_MEMORY_SCOPE_AGENT); }
__device__ __forceinline__ unsigned xb_xcc_id() { return (unsigned)__builtin_amdgcn_s_getreg((3 << 11) | 20) & 0xFu; }
#define XB_SPIN(cond, bar) do { unsigned _sp = 0; while (cond) { __builtin_amdgcn_s_sleep(1); \
    if ((++_sp & 255u) == 0u) { if (xb_ld(&(bar)[XB_TMO])) break; if (_sp > XB_SPIN_CAP) { atomicAdd(&(bar)[XB_TMO], 1u); break; } } } } while (0)

struct XcdBarrier {
    unsigned* bar; unsigned x;
    volatile LAS unsigned* st;
};

__device__ __forceinline__ XcdBarrier xcd_barrier_post(unsigned* bar, volatile LAS unsigned* st) {
    XcdBarrier b; b.bar = bar; b.x = xb_xcc_id(); b.st = st;
    if (threadIdx.x == 0) (void)xb_add(&bar[XB_XCNT(b.x)], 1u);
    return b;
}
__device__ __forceinline__ void xcd_barrier_complete(unsigned* bar, unsigned x, unsigned& nloc, unsigned& nx) {
    const unsigned G = gridDim.x * gridDim.y * gridDim.z;
    unsigned sum, cnt, mine, sp = 0u;
    for (;;) {
        sum = 0u; cnt = 0u; mine = 0u;
#pragma unroll
        for (unsigned j = 0; j < 16; ++j) { const unsigned c = xb_ld(&bar[XB_XCNT(j)]); sum += c; cnt += (c > 0u) ? 1u : 0u; mine = (j == x) ? c : mine; }
        if (sum == G) break;
        __builtin_amdgcn_s_sleep(1);
        if ((++sp & 255u) == 0u) { if (xb_ld(&bar[XB_TMO])) break; if (sp > XB_SPIN_CAP) { atomicAdd(&bar[XB_TMO], 1u); break; } }
    }
    nloc = mine > 0u ? mine : 1u; nx = cnt > 0u ? cnt : 1u;
}

__device__ __forceinline__ void xcd_barrier(const XcdBarrier& b) {
    asm volatile("s_waitcnt vmcnt(0)" ::: "memory");
    __syncthreads();
    if (threadIdx.x == 0) {
        unsigned* bar = b.bar;
        __builtin_amdgcn_s_waitcnt(0);
        unsigned nloc = b.st[0], nx = b.st[1];
        if (nloc == 0u) { xcd_barrier_complete(bar, b.x, nloc, nx); b.st[0] = nloc; b.st[1] = nx; }
        const unsigned old = xb_add(&bar[XB_XSUB(b.x)], 1u);
        const unsigned gen = old / nloc;
        if (old + 1u == (gen + 1u) * nloc) {
            __builtin_amdgcn_fence(__ATOMIC_RELEASE, "agent");
            asm volatile("s_waitcnt vmcnt(0)" ::: "memory");
            const unsigned og = xb_add(&bar[XB_TOP], 1u);
            const unsigned tg = og / nx;
            if (og + 1u == (tg + 1u) * nx) xb_add(&bar[XB_TOPGEN], 1u);
            else XB_SPIN(xb_ld(&bar[XB_TOPGEN]) == tg, bar);
            __builtin_amdgcn_fence(__ATOMIC_ACQUIRE, "agent");
            xb_add(&bar[XB_XGEN(b.x)], 1u);
            asm volatile("s_waitcnt vmcnt(0)" ::: "memory");
        } else {
            XB_SPIN(xb_ld(&bar[XB_XGEN(b.x)]) == gen, bar);
            __builtin_amdgcn_fence(__ATOMIC_ACQUIRE, "agent");
            asm volatile("s_waitcnt vmcnt(0)" ::: "memory");
        }
    }
    __syncthreads();
}

#ifndef XP_MIX
#define XP_MIX 0
#endif
#ifndef XP_CTX
#define XP_CTX 0
#endif
#ifndef XP_P5
#define XP_P5 0
#endif
#ifndef XP_NORM
#define XP_NORM 0
#endif
#ifndef XP_PRO
#define XP_PRO 0
#endif
#ifndef XP_GST
#define XP_GST 0
#endif
__global__ void __launch_bounds__(NTHR, 2) fwd_megakernel(Params pk) {
    extern __shared__ __attribute__((aligned(16))) unsigned char lds[];
    if (threadIdx.x == 0) *(Params*)(lds + PARAM_OFF) = pk;
    if (threadIdx.x < 16) ((unsigned*)(lds + 131072))[threadIdx.x] = 0u;
    __syncthreads();
    (void)xcd_barrier_post((unsigned*)(pk.ws + WS_BAR), (volatile LAS unsigned*)((LAS unsigned char*)lds + 131072));
#pragma unroll 1
    for (int ph = 0; ph < 37; ++ph) {
        if (ph > 0) { const int l_ = (ph - 1) / 9, st_ = (ph - 1) % 9;
            if (((st_ == 3 || st_ == 4) && (l_ % 3) != 0) || st_ == 6 || st_ == 0) continue; }
        asm volatile("" ::: "memory");
        Params p;
        { const unsigned* src = (const unsigned*)(lds + PARAM_OFF); unsigned* dstw = (unsigned*)&p;
#pragma unroll
          for (int i = 0; i < (int)(sizeof(Params) / 4); ++i) dstw[i] = (unsigned)__builtin_amdgcn_readfirstlane((int)src[i]); }
#define GP(f) do { __attribute__((address_space(1))) char* g_ = (__attribute__((address_space(1))) char*)(char*)(p.f); asm volatile("" : "+s"(g_)); p.f = (decltype(p.f))(char*)g_; } while (0)
        GP(x); GP(c); GP(ctx); GP(c_ctx); GP(ada_w); GP(ada_b); GP(norm_g); GP(final_g); GP(mlp_w1); GP(mlp_w2); GP(a_w_in); GP(a_w_gate); GP(a_b_gate); GP(a_head_g); GP(a_w_out);
        GP(b_w_qkv); GP(b_sinks); GP(b_w_out); GP(c_w_in); GP(c_conv_w); GP(c_conv_b); GP(c_w_out); GP(out); GP(ws);
#undef GP
        unsigned char* ws = p.ws;
        const int G = gridDim.x, bx = blockIdx.x;
        LAS unsigned char* ldsl = (LAS unsigned char*)lds;
        if (ph == 0) { phase_prologue(p, lds);
            { unsigned* c0 = (unsigned*)(ws + WS_XCNT) + 8 * 64 * 64 + 64 * 15;
              if (threadIdx.x == 0) { unsigned sp = 0; while (__hip_atomic_load(c0, __ATOMIC_RELAXED, __HIP_MEMORY_SCOPE_AGENT) < 96u) { __builtin_amdgcn_s_sleep(2); if (++sp > (1u << 22)) break; }
                  __builtin_amdgcn_fence(__ATOMIC_ACQUIRE, "agent"); asm volatile("s_waitcnt vmcnt(0)" ::: "memory"); }
              __syncthreads(); }
            phase_norm(p, p.x, p.ctx, MT, p.norm_g, (const float*)(ws + WS_MOD), (const float*)(ws + WS_MOD) + 1024, 0); }
        else {
            const int l = (ph - 1) / 9, step = (ph - 1) % 9, kind = l % 3, jx = l / 3;
            const bool ctx_out = l != 3;
            const float* ml = (const float*)(ws + WS_MOD) + (size_t)l * 3 * 6144;
            bf16* XN = (bf16*)(ws + WS_XN); bf16* HG = (bf16*)(ws + WS_HG); bf16* ACT = (bf16*)(ws + WS_ACT);
            unsigned* cctr = (unsigned*)(ws + WS_XCNT) + 8 * 64 * 64;
            if (step == 0) { }
            else if (step == 1) {
                const bf16* XNC = XN + (size_t)ML * D;
                unsigned* wc_ = l > 0 ? cctr + 64 * (2 * l) : nullptr;
                if (l > 0) ctx_norm_part(p, p.norm_g + (size_t)(l * 2 + 0) * D, ml + 0 * 1024, ml + 1 * 1024, 4, wc_);
                if (kind == 0) { const bf16* W = (const bf16*)(ws + WS_AIN) + (size_t)jx * 3328 * D;
                    { pg8::Gemm g{XN, W, ML, 3072, D}; pg8::StaticOrder S; S.init(ML, 3072, G, bx);
                      pg8::EpiStore<0> E{ACT, 3072};
                      pg8::gemm_phase<pg8::EpiStore<0>, pg8::StaticOrder, true, true>(ldsl, g, S, E); }
                    ctx_gemm<0>(lds, XNC, W, 3072, D, 1, ACT, 3072, nullptr, nullptr, 1.f, 0, wc_);
                    ctx_gemm<4>(lds, XN, W + (size_t)3072 * D, 32, D, 1, nullptr, 0, (float*)(ws + WS_G), p.a_b_gate + jx * 32, 1.f, 0, wc_, 0, MT / 128, true); }
                else if (kind == 1) { const bf16* W = (const bf16*)(ws + WS_BQKV);
                    { pg8::Gemm g{XN, W, ML, 1536, D}; pg8::StaticOrder S; S.init(ML, 1536, G, bx);
                      pg8::EpiQkvRope E{ACT, (const float*)(ws + WS_ROPE), (const float*)(ws + WS_ROPE) + 2048};
                      pg8::gemm_phase<pg8::EpiQkvRope, pg8::StaticOrder, true, true>(ldsl, g, S, E); }
                    ctx_gemm<0>(lds, XNC, W, 1536, D, 1, ACT, 1536, nullptr, nullptr, 0.18033688011112042f, 1024, wc_); }
                else { const bf16* W = (const bf16*)(ws + WS_CIN);
                    { pg8::Gemm g{XN, W, ML, 3072, D}; pg8::StaticOrder S; S.init(ML, 3072, G, bx);
                      pg8::EpiStore<0> E{ACT, 3072};
                      pg8::gemm_phase<pg8::EpiStore<0>, pg8::StaticOrder, true, true>(ldsl, g, S, E); }
                    ctx_gemm<0>(lds, XNC, W, 3072, D, 1, ACT, 3072, nullptr, nullptr, 1.f, 0, wc_); }
            }
            else if (step == 2) {
                if (kind == 0) phase_mlstm_local(p, lds); else if (kind == 1) phase_attn(p, lds, ctx_out); else phase_conv(p, MT); }
            else if (step == 3) { phase_mlstm_scan(p); }
            else if (step == 4) { phase_mlstm_out(p, lds, jx, ctx_out); }
            else if (step == 5 || step == 8) {
                const bool dn = step == 8;
                const bf16* wout = kind == 0 ? (const bf16*)(ws + WS_AOUT) + (size_t)jx * D * D : (kind == 1 ? (const bf16*)(ws + WS_BOUT) : (const bf16*)(ws + WS_COUT));
                const bf16* Aop = dn ? ACT : HG; const bf16* W = dn ? (const bf16*)(ws + WS_W2) + (size_t)l * D * FF : wout; const int Kd = dn ? FF : D;
                const int fin = (dn && l == 3) ? 1 : 0, fi = 2 * l + (dn ? 1 : 0);
                const float* mn = dn ? ml + 3 * 6144 : ml;
                const float* ng = fin ? p.final_g : p.norm_g + (size_t)(dn ? (l + 1) * 2 : l * 2 + 1) * D;
                const float* nsh = fin ? ml : mn + (dn ? 0 : 3) * 1024; const float* nsc = fin ? ml : mn + (dn ? 1 : 4) * 1024;
                { pg8::Gemm g{Aop, W, ML, D, Kd}; pg8::StaticOrder S; S.init(ML, D, G, bx);
                  pg8::EpiResidNorm E{p.out, (l == 0 && !dn) ? p.x : p.out, XN, ml + (dn ? 5 : 2) * 1024, ng, nsh, nsc, (unsigned*)(ws + WS_XSLOT) + (size_t)fi * ML * 4, (unsigned*)(ws + WS_XCNT) + fi * 64 * 64, fin};
                  pg8::gemm_phase<pg8::EpiResidNorm, pg8::StaticOrder, false, true>(ldsl, g, S, E); }
                if (ctx_out) ctx_gemm<3>(lds, Aop + (size_t)ML * Kd, W, D, Kd, 4, nullptr, 0, (float*)(ws + WS_PART), ml + 2 * 6144 + (dn ? 5 : 2) * 1024, 1.f, 0, nullptr);
            }
            else { const bf16* W = (const bf16*)(ws + WS_W1) + (size_t)l * D * FF;
                unsigned* wc_ = cctr + 64 * (2 * l + 1);
                if (ctx_out) ctx_norm_part(p, p.norm_g + (size_t)(l * 2 + 1) * D, ml + 3 * 1024, ml + 4 * 1024, 4, wc_);
                { pg8::Gemm g{XN, W, ML, FF, D}; pg8::StaticOrder S; S.init(ML, FF, G, bx);
                  pg8::EpiStore<1> E{ACT, FF};
                  pg8::gemm_phase<pg8::EpiStore<1>, pg8::StaticOrder, true, true>(ldsl, g, S, E); }
                if (ctx_out) ctx_gemm<1>(lds, XN + (size_t)ML * D, W, FF, D, 1, ACT, FF, nullptr, nullptr, 1.f, 0, wc_); }
        }
        if (ph == 36) break;
        { XcdBarrier xb; xb.bar = (unsigned*)(ws + WS_BAR); xb.x = xb_xcc_id(); xb.st = (volatile LAS unsigned*)(ldsl + 131072); xcd_barrier(xb); }
    }
}

extern "C" void kernel_launch(void* const* d_in, const int* in_sizes, int n_in, void* d_out, int out_size, void* d_ws, size_t ws_size, hipStream_t stream) {
    static int grid = 0;
    if (grid == 0) {
        if (n_in != 22 || ws_size < WS_END) { fprintf(stderr, "kernel_launch: unexpected n_in %d / ws_size %zu (need %zu)\n", n_in, ws_size, (size_t)WS_END); grid = -1; return; }
        int dev = 0, cus = 0, per_cu = 0;
        hipGetDevice(&dev); hipDeviceGetAttribute(&cus, hipDeviceAttributeMultiprocessorCount, dev);
        if (hipFuncSetAttribute((const void*)fwd_megakernel, hipFuncAttributeMaxDynamicSharedMemorySize, LDS_BYTES) != hipSuccess) { fprintf(stderr, "kernel_launch: hipFuncSetAttribute failed\n"); grid = -1; return; }
        if (hipOccupancyMaxActiveBlocksPerMultiprocessor(&per_cu, (const void*)fwd_megakernel, NTHR, LDS_BYTES) != hipSuccess || per_cu < 1) { fprintf(stderr, "kernel_launch: occupancy query reports %d\n", per_cu); per_cu = 1; }
        (void)hipGetLastError();
        if (cus != 256) { fprintf(stderr, "kernel_launch: built for a 256-CU device (one 256x256 unit per workgroup in the fused residual+norm GEMM phases); found %d\n", cus); grid = -1; return; }
        grid = cus * 1;
    }
    if (grid < 0) return;
    if (hipMemsetAsync((char*)d_ws + WS_XCNT, 0, ZERO_BYTES, stream) != hipSuccess) { fprintf(stderr, "kernel_launch: memset failed\n"); return; }
    Params p{};
    const float** pp = (const float**)&p;
    for (int i = 0; i < 22; ++i) pp[i] = (const float*)d_in[i];
    p.out = (float*)d_out; p.ws = (unsigned char*)d_ws;
    void* args[] = {&p};
    hipError_t e = hipLaunchCooperativeKernel((const void*)fwd_megakernel, dim3(grid), dim3(NTHR), args, LDS_BYTES, stream);
    if (e != hipSuccess) fprintf(stderr, "cooperative launch failed: %s (grid %d)\n", hipGetErrorString(e), grid);
}
```
